# Optimizing an MI355X kernel written in HIP

```python
import math
import jax, jax.numpy as jnp
from jax import lax
import numpy as np

D_MODEL = 1024
BATCH = 8
SEQ = 4096
DEPTH = 2

N_EVEN = (DEPTH + 1) // 2
N_ODD = DEPTH // 2

DA_HEADS = 4
DA_DIM = 64
DA_VDIM = 2 * DA_DIM
RET_HEADS = 4
RET_QK = 64
RET_V = 128
RET_CHUNK = 128
RET_THETA = 10000.0
GLA_HEADS = 4
GLA_QK = 128
GLA_V = 256
GLA_RANK = 16
GLA_TAU = 16.0
GLA_CHUNK = 64
D_FF = 2816
ROPE_THETA = 500000.0
ROPE_FRAC = 4
Q_BLOCK = 128
EPS = 1e-6

AB_SPLITS = (DA_HEADS * 2 * DA_DIM, DA_HEADS * 2 * DA_DIM, DA_HEADS * DA_VDIM,
             RET_HEADS * RET_QK, RET_HEADS * RET_QK, RET_HEADS * RET_V, RET_HEADS * RET_V)
AB_IN = sum(AB_SPLITS)
AB_OUT = DA_HEADS * DA_VDIM + RET_HEADS * RET_V
C_SPLITS = (GLA_HEADS * GLA_QK, GLA_HEADS * GLA_QK, GLA_HEADS * GLA_V, GLA_HEADS * GLA_V,
            GLA_RANK, GLA_RANK)
C_IN = sum(C_SPLITS)
C_OUT = GLA_HEADS * GLA_V

kernel_name = "hybrid_diffattn_retention_gla_macaron"


def _split(t, widths):
    idx = np.cumsum(widths)[:-1].tolist()
    return jnp.split(t, idx, axis=-1)


def _heads(t, n):
    b, s, _ = t.shape
    return t.reshape(b, s, n, -1).transpose(0, 2, 1, 3)


def _merge_heads(t):
    b, n, s, d = t.shape
    return t.transpose(0, 2, 1, 3).reshape(b, s, n * d)


def rmsnorm(x, g):
    xf = x.astype(jnp.float32)
    y = xf * lax.rsqrt(jnp.mean(xf * xf, axis=-1, keepdims=True) + EPS)
    return (y * g.astype(jnp.float32)).astype(x.dtype)


def rope_tables(positions, dim, theta):
    inv = 1.0 / (theta ** (jnp.arange(0, dim, 2, dtype=jnp.float32) / dim))
    ang = positions.astype(jnp.float32)[:, None] * inv[None, :]
    return jnp.cos(ang), jnp.sin(ang)


def apply_rope(x, cos, sin):
    half = x.shape[-1] // 2
    x1, x2 = x[..., :half], x[..., half:]
    c, s = cos.astype(x.dtype), sin.astype(x.dtype)
    return jnp.concatenate([x1 * c - x2 * s, x1 * s + x2 * c], axis=-1)


def apply_partial_rope(x, cos, sin):
    r = x.shape[-1] // ROPE_FRAC
    return jnp.concatenate([apply_rope(x[..., :r], cos, sin), x[..., r:]], axis=-1)


def swiglu(x, w_gate, w_up, w_down):
    return (jax.nn.silu(x @ w_gate) * (x @ w_up)) @ w_down


def diff_attention(q, k, v, lam):
    b, h, _, s, d = q.shape
    nb = s // Q_BLOCK
    q = q * (d ** -0.5)
    qb = q.reshape(b, h, 2, nb, Q_BLOCK, d).transpose(3, 0, 1, 2, 4, 5)

    def block(qblk):
        sc = jnp.einsum('bhcqd,bhckd->bhcqk', qblk, k).astype(jnp.float32)
        p = jax.nn.softmax(sc, axis=-1)
        a = p[:, :, 0] - lam * p[:, :, 1]
        return jnp.einsum('bhqk,bhkv->bhqv', a.astype(v.dtype), v)

    o = lax.map(block, qb)
    return o.transpose(1, 2, 0, 3, 4).reshape(b, h, s, v.shape[-1])


def retention_dir(q, k, v, log_gamma):
    b, h, s, dk = q.shape
    dv = v.shape[-1]
    c = RET_CHUNK
    n = s // c
    qc = q.reshape(b, h, n, c, dk)
    kc = k.reshape(b, h, n, c, dk)
    vc = v.reshape(b, h, n, c, dv)
    idx = jnp.arange(c, dtype=jnp.float32)
    lg = log_gamma.astype(jnp.float32)
    diff = idx[:, None] - idx[None, :]
    intra_decay = jnp.where(diff >= 0, jnp.exp(lg[:, None, None] * jnp.maximum(diff, 0.0)[None]), 0.0)
    sc = jnp.einsum('bhncd,bhnjd->bhncj', qc, kc) * intra_decay[None, :, None]
    o_intra = jnp.einsum('bhncj,bhnjv->bhncv', sc, vc)
    k_dec = jnp.exp(lg[:, None] * (c - 1.0 - idx)[None, :])
    q_dec = jnp.exp(lg[:, None] * (idx + 1.0)[None, :])
    kv = jnp.einsum('bhnjd,bhnjv->nbhdv', kc * k_dec[None, :, None, :, None], vc)
    chunk_decay = jnp.exp(lg * c)[None, :, None, None]

    def step(state, kv_n):
        return chunk_decay * state + kv_n, state

    _, states = lax.scan(step, jnp.zeros(kv.shape[1:], kv.dtype), kv)
    o_inter = jnp.einsum('bhncd,nbhdv->bhncv', qc * q_dec[None, :, None, :, None], states)
    return (o_intra + o_inter).reshape(b, h, s, dv).astype(v.dtype)


def gla_dir(q, k, v, log_a):
    b, h, s, dk = q.shape
    dv = v.shape[-1]
    c = GLA_CHUNK
    n = s // c
    qc = q.reshape(b, h, n, c, dk).astype(jnp.float32)
    kc = k.reshape(b, h, n, c, dk).astype(jnp.float32)
    vc = v.reshape(b, h, n, c, dv).astype(jnp.float32)
    cum = jnp.cumsum(log_a.reshape(b, h, n, c, dk), axis=3)
    last = cum[:, :, :, -1:]
    q_g = qc * jnp.exp(cum)
    sc = jnp.einsum('bhncd,bhnjd->bhncj', q_g, kc * jnp.exp(-cum))
    mask = jnp.tril(jnp.ones((c, c), dtype=bool))
    o_intra = jnp.einsum('bhncj,bhnjv->bhncv', jnp.where(mask, sc, 0.0), vc)
    kv = jnp.einsum('bhnjd,bhnjv->nbhdv', kc * jnp.exp(last - cum), vc)
    dec = jnp.exp(last[:, :, :, 0]).transpose(2, 0, 1, 3)[..., None]

    def step(state, inp):
        kv_n, dec_n = inp
        return dec_n * state + kv_n, state

    _, states = lax.scan(step, jnp.zeros(kv.shape[1:], jnp.float32), (kv, dec))
    o_inter = jnp.einsum('bhncd,nbhdv->bhncv', q_g, states)
    return (o_intra + o_inter).reshape(b, h, s, dv).astype(v.dtype)


def _flip(t):
    return jnp.flip(t, axis=2)


def mixer_ab(h, w_in, lq1, lk1, lq2, lk2, da_norm, ret_logit_f, ret_logit_b, ret_norm, w_out,
             cos_a, sin_a, cos_r, sin_r, lam_init):
    b, s, _ = h.shape
    qa, ka, va, qr, kr, vr, gr = _split(h @ w_in, AB_SPLITS)
    qa = qa.reshape(b, s, DA_HEADS, 2, DA_DIM).transpose(0, 2, 3, 1, 4)
    ka = ka.reshape(b, s, DA_HEADS, 2, DA_DIM).transpose(0, 2, 3, 1, 4)
    qa = apply_partial_rope(qa, cos_a, sin_a)
    ka = apply_partial_rope(ka, cos_a, sin_a)
    va = _heads(va, DA_HEADS)
    lam = (jnp.exp(jnp.sum(lq1.astype(jnp.float32) * lk1.astype(jnp.float32)))
           - jnp.exp(jnp.sum(lq2.astype(jnp.float32) * lk2.astype(jnp.float32))) + lam_init)
    oa = diff_attention(qa, ka, va, lam)
    oa = rmsnorm(oa, da_norm) * (1.0 - lam_init)
    qr = apply_rope(_heads(qr, RET_HEADS), cos_r, sin_r)
    kr = apply_rope(_heads(kr, RET_HEADS), cos_r, sin_r) * (RET_QK ** -0.5)
    vr = _heads(vr, RET_HEADS)
    lg_f = jax.nn.log_sigmoid(ret_logit_f.astype(jnp.float32))
    lg_b = jax.nn.log_sigmoid(ret_logit_b.astype(jnp.float32))
    orr = retention_dir(qr, kr, vr, lg_f) + _flip(retention_dir(_flip(qr), _flip(kr), _flip(vr), lg_b))
    orr = _merge_heads(rmsnorm(orr, ret_norm)) * jax.nn.silu(gr)
    return jnp.concatenate([_merge_heads(oa), orr], axis=-1) @ w_out


def mixer_c(h, w_in, w2_f, b_f, w2_b, b_b, gla_norm, w_out):
    q, k, v, g, lr_f, lr_b = _split(h @ w_in, C_SPLITS)
    q = _heads(q, GLA_HEADS) * (GLA_QK ** -0.5)
    k = _heads(k, GLA_HEADS)
    v = _heads(v, GLA_HEADS)
    la_f = _heads(jax.nn.log_sigmoid((lr_f @ w2_f + b_f).astype(jnp.float32)) / GLA_TAU, GLA_HEADS)
    la_b = _heads(jax.nn.log_sigmoid((lr_b @ w2_b + b_b).astype(jnp.float32)) / GLA_TAU, GLA_HEADS)
    o = gla_dir(q, k, v, la_f) + _flip(gla_dir(_flip(q), _flip(k), _flip(v), _flip(la_b)))
    o = _merge_heads(rmsnorm(o, gla_norm)) * jax.nn.silu(g)
    return o @ w_out


def setup_inputs(seed: int = 0) -> dict:
    key = jax.random.key(seed)
    ks = iter(jax.random.split(key, 40))

    def nrm(shape, scale):
        return jax.random.normal(next(ks), shape, jnp.float32) * scale

    def gain(shape):
        return 1.0 + nrm(shape, 0.02)

    gammas = 1.0 - 2.0 ** (-5.0 - np.arange(RET_HEADS, dtype=np.float64))
    ret_base = jnp.asarray(np.log(gammas / (1.0 - gammas)).astype(np.float32))
    return {
        "x": nrm((BATCH, SEQ, D_MODEL), 1.0),
        "positions": jnp.arange(SEQ, dtype=jnp.int32),
        "ffn1_norm": gain((DEPTH, D_MODEL)),
        "ffn1_w_gate": nrm((DEPTH, D_MODEL, D_FF), D_MODEL ** -0.5),
        "ffn1_w_up": nrm((DEPTH, D_MODEL, D_FF), D_MODEL ** -0.5),
        "ffn1_w_down": nrm((DEPTH, D_FF, D_MODEL), D_FF ** -0.5),
        "ffn2_norm": gain((DEPTH, D_MODEL)),
        "ffn2_w_gate": nrm((DEPTH, D_MODEL, D_FF), D_MODEL ** -0.5),
        "ffn2_w_up": nrm((DEPTH, D_MODEL, D_FF), D_MODEL ** -0.5),
        "ffn2_w_down": nrm((DEPTH, D_FF, D_MODEL), D_FF ** -0.5),
        "ab_norm": gain((N_EVEN, D_MODEL)),
        "ab_w_in": nrm((N_EVEN, D_MODEL, AB_IN), D_MODEL ** -0.5),
        "da_lq1": nrm((N_EVEN, DA_DIM), 0.1),
        "da_lk1": nrm((N_EVEN, DA_DIM), 0.1),
        "da_lq2": nrm((N_EVEN, DA_DIM), 0.1),
        "da_lk2": nrm((N_EVEN, DA_DIM), 0.1),
        "da_norm": gain((N_EVEN, DA_VDIM)),
        "ret_logit_f": ret_base[None, :] + nrm((N_EVEN, RET_HEADS), 0.1),
        "ret_logit_b": ret_base[None, :] + nrm((N_EVEN, RET_HEADS), 0.1),
        "ret_norm": gain((N_EVEN, RET_V)),
        "ab_w_out": nrm((N_EVEN, AB_OUT, D_MODEL), AB_OUT ** -0.5),
        "c_norm": gain((N_ODD, D_MODEL)),
        "c_w_in": nrm((N_ODD, D_MODEL, C_IN), D_MODEL ** -0.5),
        "gla_w2_f": nrm((N_ODD, GLA_RANK, GLA_HEADS * GLA_QK), GLA_RANK ** -0.5),
        "gla_b_f": nrm((N_ODD, GLA_HEADS * GLA_QK), 0.1),
        "gla_w2_b": nrm((N_ODD, GLA_RANK, GLA_HEADS * GLA_QK), GLA_RANK ** -0.5),
        "gla_b_b": nrm((N_ODD, GLA_HEADS * GLA_QK), 0.1),
        "gla_norm": gain((N_ODD, GLA_V)),
        "c_w_out": nrm((N_ODD, C_OUT, D_MODEL), C_OUT ** -0.5),
        "final_norm": gain((D_MODEL,)),
    }


def reference(x, positions, ffn1_norm, ffn1_w_gate, ffn1_w_up, ffn1_w_down,
              ffn2_norm, ffn2_w_gate, ffn2_w_up, ffn2_w_down,
              ab_norm, ab_w_in, da_lq1, da_lk1, da_lq2, da_lk2, da_norm,
              ret_logit_f, ret_logit_b, ret_norm, ab_w_out,
              c_norm, c_w_in, gla_w2_f, gla_b_f, gla_w2_b, gla_b_b, gla_norm, c_w_out,
              final_norm):
    cos_a, sin_a = rope_tables(positions, DA_DIM // ROPE_FRAC, ROPE_THETA)
    cos_r, sin_r = rope_tables(positions, RET_QK, RET_THETA)
    for layer in range(DEPTH):
        i = layer // 2
        x = x + 0.5 * swiglu(rmsnorm(x, ffn1_norm[layer]), ffn1_w_gate[layer], ffn1_w_up[layer], ffn1_w_down[layer])
        if layer % 2 == 0:
            lam_init = 0.8 - 0.6 * math.exp(-0.3 * layer)
            x = x + mixer_ab(rmsnorm(x, ab_norm[i]), ab_w_in[i], da_lq1[i], da_lk1[i], da_lq2[i], da_lk2[i],
                             da_norm[i], ret_logit_f[i], ret_logit_b[i], ret_norm[i], ab_w_out[i],
                             cos_a, sin_a, cos_r, sin_r, lam_init)
        else:
            x = x + mixer_c(rmsnorm(x, c_norm[i]), c_w_in[i], gla_w2_f[i], gla_b_f[i], gla_w2_b[i], gla_b_b[i],
                            gla_norm[i], c_w_out[i])
        x = x + 0.5 * swiglu(rmsnorm(x, ffn2_norm[layer]), ffn2_w_gate[layer], ffn2_w_up[layer], ffn2_w_down[layer])
    return rmsnorm(x, final_norm)
```

```cpp
#include <hip/hip_runtime.h>
#include <hip/hip_cooperative_groups.h>
#include <cstdio>
#include <cstdint>
namespace cg = cooperative_groups;
namespace pg8 {
#define PG8_LAS __attribute__((address_space(3)))
typedef unsigned short bf16_t;
typedef short bf16x8 __attribute__((ext_vector_type(8)));
typedef float f32x4 __attribute__((ext_vector_type(4)));
typedef unsigned u32x4 __attribute__((ext_vector_type(4)));
constexpr int BM = 256, BK = 64, HALF = 128, HTB = HALF * BK * 2  , STAGE_BYTES = 8 * HTB, NXCD = 8, WGM = 8;

__host__ __device__ __forceinline__ int lds_byte(int r, int c) { const int st = (r >> 4) * 2 + (c >> 5), rr = r & 15, cc = c & 31, ob = rr * 64 + cc * 2; return st * 1024 + (ob ^ (((ob >> 9) & 1) << 5)); }
__host__ __device__ __forceinline__ void stage_rc(int b, int& R, int& C) { const int st = b / 1024, sb = b % 1024, swz = sb ^ (((sb >> 9) & 1) << 5); R = (st >> 1) * 16 + swz / 64; C = (st & 1) * 32 + (swz % 64) / 2; }
__host__ __device__ __forceinline__ int perm32(int rho) { const int n = rho >> 4, i = rho & 15; return 8 * (i >> 2) + 4 * n + (i & 3); }

struct Unit { int pm, pn; };
struct Gemm { const bf16_t* A; const bf16_t* Bt; int M, N, K; };

struct StaticOrder {
    int nM, nN, nwg, G, c;
    __host__ __device__ void init(int M, int N, int G_, int c_) { nM = M / BM; nN = N / BM; nwg = nM * nN; G = G_; c = c_; }
    __host__ __device__ bool next(int i, Unit& u) const {
        const long L = (long)i * G + c; if (L >= nwg) return false;
        int wgid = (int)L; { const int q = nwg / NXCD, r = nwg % NXCD, xcd = wgid % NXCD, off = wgid / NXCD; wgid = (xcd < r ? xcd * (q + 1) : r * (q + 1) + (xcd - r) * q) + off; }
        const int nig = WGM * nN, gid = wgid / nig, fm = gid * WGM, gsz = (nM - fm) < WGM ? (nM - fm) : WGM;
        u.pm = fm + ((wgid % nig) % gsz); u.pn = (wgid % nig) / gsz; return true;
    }
    __device__ __forceinline__ void a_ready(const Unit&) const {}
    __device__ __forceinline__ void done(const Unit&) const {}
};
__device__ __forceinline__ unsigned cvt_pk_bf16(float lo, float hi) { unsigned r; asm volatile("v_cvt_pk_bf16_f32 %0, %1, %2" : "=v"(r) : "v"(lo), "v"(hi)); return r; }
typedef float f32x2 __attribute__((ext_vector_type(2)));
template <class Epi, class Sched, bool ALIGN_EPI = false, bool SP2 = false>
__device__ __forceinline__ void gemm_phase(PG8_LAS unsigned char* lds, const Gemm g, const Sched& S, const Epi& E) {
    int tid_ = threadIdx.x; asm volatile("" : "+v"(tid_)); const int tid = tid_, wid = __builtin_amdgcn_readfirstlane(tid >> 6), lane = tid & 63, wr = wid >> 2, wc = wid & 3, fr = lane & 15, fq = lane >> 4;
    const int K = g.K, nt = K / BK;
    unsigned voffA[2], voffB[2];
#pragma unroll
    for (int i = 0; i < 2; ++i) { int R, C; stage_rc(tid * 16 + i * 8192, R, C); const int Rb = Epi::PERM ? ((R & ~31) + perm32(R & 31)) : R;
        voffA[i] = (unsigned)(R * K + C) * 2u; voffB[i] = (unsigned)(Rb * K + C) * 2u; }
    const size_t kstep = (size_t)(BK * 2);
    const size_t hstep = (size_t)HALF * K * 2;
    const size_t tstep = 2 * hstep;
    const unsigned ldsw = (unsigned)wid * 1024u;
    const int aoff = lds_byte(wr * 64 + fr, fq * 8), boff = lds_byte(wc * 32 + fr, fq * 8);
#define PG8_SA(b, h) (((b) * 2 + (h)) * HTB)
#define PG8_SB(b, h) ((4 + (b) * 2 + (h)) * HTB)
#define PG8_STAGE(bufoff, gbase, voff) do { _Pragma("unroll") for (int _i = 0; _i < 2; ++_i) \
        __builtin_amdgcn_global_load_lds((const unsigned*)((const char*)(gbase) + (voff)[_i]), (PG8_LAS unsigned*)(lds + (bufoff) + ldsw + _i * 8192), 16, 0, 0); } while (0)
#define PG8_LDA(dst, b, h) do { _Pragma("unroll") for (int m = 0; m < 4; ++m) _Pragma("unroll") for (int k = 0; k < 2; ++k) dst[m][k] = *(const PG8_LAS bf16x8*)(lds + PG8_SA(b, h) + aoff + m * 2048 + k * 1024); } while (0)
#define PG8_LDB(dst, b, h) do { _Pragma("unroll") for (int n = 0; n < 2; ++n) _Pragma("unroll") for (int k = 0; k < 2; ++k) dst[n][k] = *(const PG8_LAS bf16x8*)(lds + PG8_SB(b, h) + boff + n * 2048 + k * 1024); } while (0)
#define PG8_MMA(ai, bj, At, Bt) do { __builtin_amdgcn_s_setprio(1); _Pragma("unroll") for (int m = 0; m < 4; ++m) _Pragma("unroll") for (int n = 0; n < 2; ++n) _Pragma("unroll") for (int k = 0; k < 2; ++k) \
        acc[ai][bj][m][n] = __builtin_amdgcn_mfma_f32_16x16x32_bf16(Bt[n][k], At[m][k], acc[ai][bj][m][n], 0, 0, 0); __builtin_amdgcn_s_setprio(0); } while (0)
#define PG8_WAIT_V(n) asm volatile("s_waitcnt vmcnt(" #n ")" ::: "memory")
#define PG8_WAIT_L(n) asm volatile("s_waitcnt lgkmcnt(" #n ")" ::: "memory")
#define PG8_BAR __builtin_amdgcn_s_barrier()
#define PG8_SCHED __builtin_amdgcn_sched_barrier(0)
    Unit cur, nxt; int ui = 0;
    if (!S.next(0, cur)) return;
    f32x4 acc[2][2][4][2];
#pragma unroll
    for (int a = 0; a < 2; ++a)
#pragma unroll
        for (int b = 0; b < 2; ++b)
#pragma unroll
            for (int m = 0; m < 4; ++m)
#pragma unroll
                for (int n = 0; n < 2; ++n) acc[a][b][m][n] = (f32x4){0.f, 0.f, 0.f, 0.f};
    bf16x8 At[4][2], B0[2][2], B1[2][2];
    const char* cA = (const char*)g.A + (size_t)cur.pm * tstep; const char* cB = (const char*)g.Bt + (size_t)cur.pn * tstep;
    S.a_ready(cur);
    if constexpr (SP2) {
        PG8_STAGE(PG8_SB(0, 0), cB, voffB); PG8_STAGE(PG8_SB(0, 1), cB + hstep, voffB); PG8_STAGE(PG8_SA(0, 0), cA, voffA); PG8_STAGE(PG8_SA(0, 1), cA + hstep, voffA);
        if (wr == 1) PG8_BAR;
        PG8_WAIT_V(2); PG8_BAR;
        PG8_STAGE(PG8_SB(1, 0), cB + kstep, voffB); PG8_STAGE(PG8_SA(1, 0), cA + kstep, voffA); PG8_STAGE(PG8_SB(1, 1), cB + hstep + kstep, voffB);
        PG8_WAIT_V(6); PG8_BAR;
    } else {
        PG8_STAGE(PG8_SB(0, 0), cB, voffB); PG8_STAGE(PG8_SA(0, 0), cA, voffA); PG8_STAGE(PG8_SB(0, 1), cB + hstep, voffB); PG8_STAGE(PG8_SA(0, 1), cA + hstep, voffA);
        if (wr == 1) PG8_BAR;
        PG8_WAIT_V(4); PG8_BAR;
        PG8_STAGE(PG8_SB(1, 0), cB + kstep, voffB); PG8_STAGE(PG8_SA(1, 0), cA + kstep, voffA); PG8_STAGE(PG8_SB(1, 1), cB + hstep + kstep, voffB);
        PG8_WAIT_V(6); PG8_BAR;
    }
    for (;;) {
        const bool has_next = S.next(ui + 1, nxt);
        const char* nA = has_next ? (const char*)g.A + (size_t)nxt.pm * tstep : cA; const char* nB = has_next ? (const char*)g.Bt + (size_t)nxt.pn * tstep : cB;
        for (int t = 0; t < nt; t += 2) {
            const bool last = (t == nt - 2);
            const char* a1 = cA + (size_t)(t + 1) * kstep;
            const char* a2 = last ? nA : cA + (size_t)(t + 2) * kstep; const char* b2 = last ? nB : cB + (size_t)(t + 2) * kstep;
            const char* a3 = a2 + kstep; const char* b3 = b2 + kstep;
            if (last && has_next) S.a_ready(nxt);
            if constexpr (SP2) {
            PG8_LDB(B0, 0, 0); PG8_LDB(B1, 0, 1); PG8_SCHED; PG8_LDA(At, 0, 0); PG8_STAGE(PG8_SA(1, 1), a1 + hstep, voffA);
            PG8_WAIT_V(8); PG8_WAIT_L(0); PG8_BAR; PG8_MMA(0, 0, At, B0); PG8_MMA(0, 1, At, B1); PG8_BAR; PG8_SCHED;
            PG8_LDA(At, 0, 1); PG8_STAGE(PG8_SB(0, 0), b2, voffB); PG8_STAGE(PG8_SB(0, 1), b2 + hstep, voffB); PG8_STAGE(PG8_SA(0, 0), a2, voffA);
            PG8_WAIT_V(8); PG8_WAIT_L(0); PG8_BAR; PG8_MMA(1, 0, At, B0); PG8_MMA(1, 1, At, B1); PG8_BAR; PG8_SCHED;
            PG8_LDB(B0, 1, 0); PG8_LDB(B1, 1, 1); PG8_SCHED; PG8_LDA(At, 1, 0); PG8_STAGE(PG8_SA(0, 1), a2 + hstep, voffA);
            PG8_WAIT_V(8); PG8_WAIT_L(0); PG8_BAR; PG8_MMA(0, 0, At, B0); PG8_MMA(0, 1, At, B1); PG8_BAR; PG8_SCHED;
            PG8_LDA(At, 1, 1); PG8_STAGE(PG8_SB(1, 0), b3, voffB); PG8_STAGE(PG8_SB(1, 1), b3 + hstep, voffB); PG8_STAGE(PG8_SA(1, 0), a3, voffA);
            PG8_WAIT_V(8); PG8_WAIT_L(0); PG8_BAR; PG8_MMA(1, 0, At, B0); PG8_MMA(1, 1, At, B1); PG8_BAR; PG8_SCHED;
            } else {
            PG8_LDB(B0, 0, 0); PG8_SCHED; PG8_LDA(At, 0, 0); PG8_STAGE(PG8_SA(1, 1), a1 + hstep, voffA);
            PG8_WAIT_L(8); PG8_BAR; PG8_WAIT_L(0); PG8_MMA(0, 0, At, B0); PG8_BAR; PG8_SCHED;
            PG8_LDB(B1, 0, 1); PG8_STAGE(PG8_SB(0, 0), b2, voffB);
            PG8_BAR; PG8_WAIT_L(0); PG8_MMA(0, 1, At, B1); PG8_BAR;
            PG8_LDA(At, 0, 1); PG8_STAGE(PG8_SA(0, 0), a2, voffA);
            PG8_BAR; PG8_WAIT_L(0); PG8_MMA(1, 0, At, B0); PG8_BAR; PG8_SCHED;
            PG8_STAGE(PG8_SB(0, 1), b2 + hstep, voffB);
            PG8_WAIT_V(6); PG8_BAR; PG8_MMA(1, 1, At, B1); PG8_BAR;
            PG8_LDB(B0, 1, 0); PG8_SCHED; PG8_LDA(At, 1, 0); PG8_STAGE(PG8_SA(0, 1), a2 + hstep, voffA);
            PG8_WAIT_L(8); PG8_BAR; PG8_WAIT_L(0); PG8_MMA(0, 0, At, B0); PG8_BAR; PG8_SCHED;
            PG8_LDB(B1, 1, 1); PG8_STAGE(PG8_SB(1, 0), b3, voffB);
            PG8_BAR; PG8_WAIT_L(0); PG8_MMA(0, 1, At, B1); PG8_BAR;
            PG8_LDA(At, 1, 1); PG8_STAGE(PG8_SA(1, 0), a3, voffA);
            PG8_BAR; PG8_WAIT_L(0); PG8_MMA(1, 0, At, B0); PG8_BAR; PG8_SCHED;
            PG8_STAGE(PG8_SB(1, 1), b3 + hstep, voffB);
            PG8_WAIT_V(6); PG8_BAR; PG8_MMA(1, 1, At, B1); PG8_BAR;
            }
        }
        if constexpr (ALIGN_EPI) { if (wr == 0) PG8_BAR; }
        if constexpr (!Epi::AFTER_DRAIN) { E(acc, cur, wr, wc, fr, fq); S.done(cur); }
        if (!has_next) break;
#pragma unroll
        for (int a = 0; a < 2; ++a)
#pragma unroll
            for (int b = 0; b < 2; ++b)
#pragma unroll
                for (int m = 0; m < 4; ++m)
#pragma unroll
                    for (int n = 0; n < 2; ++n) acc[a][b][m][n] = (f32x4){0.f, 0.f, 0.f, 0.f};
        cur = nxt; cA = nA; cB = nB; ++ui;
        if constexpr (ALIGN_EPI) { if (wr == 1) PG8_BAR; }
    }
    PG8_WAIT_V(0);
    if constexpr (!ALIGN_EPI) { if (wr == 0) PG8_BAR; }
    PG8_BAR;
    if constexpr (Epi::AFTER_DRAIN) { E.fused(acc, cur, wr, wc, fr, fq, lds, wid, lane); S.done(cur); }
#undef PG8_SA
#undef PG8_SB
#undef PG8_STAGE
#undef PG8_LDA
#undef PG8_LDB
#undef PG8_MMA
#undef PG8_WAIT_V
#undef PG8_WAIT_L
#undef PG8_BAR
#undef PG8_SCHED
}
}
#define LAS __attribute__((address_space(3)))
#define GA1 __attribute__((address_space(1)))
typedef unsigned short bf16_t;
typedef short bf16x8 __attribute__((ext_vector_type(8)));
typedef short s16x4 __attribute__((ext_vector_type(4)));
typedef short v4i16_t __attribute__((ext_vector_type(4)));
typedef float f32x4 __attribute__((ext_vector_type(4)));
typedef float f32x16 __attribute__((ext_vector_type(16)));
typedef unsigned u32x4 __attribute__((ext_vector_type(4)));
typedef unsigned u32x2 __attribute__((ext_vector_type(2)));

constexpr int T = 32768, D = 1024, FF = 2816, SEQ = 4096, PP = 3072;
constexpr float EPS = 1e-6f;
constexpr size_t MiB = 1u << 20;
constexpr size_t WS_WGU = 1 * MiB;
constexpr size_t WS_WD = WS_WGU + 44 * MiB;
constexpr size_t WS_WIN0 = WS_WD + 22 * MiB;
constexpr size_t WS_WOUT0 = WS_WIN0 + 6 * MiB;
constexpr size_t WS_WIN1 = WS_WOUT0 + 2 * MiB;
constexpr size_t WS_WOUT1 = WS_WIN1 + 7 * MiB;
constexpr size_t WS_A = 84 * MiB;
constexpr size_t WS_B = 148 * MiB;
constexpr size_t WS_C = 340 * MiB;
constexpr size_t WS_LR = 468 * MiB;
constexpr size_t WS_DEC = 472 * MiB;
constexpr size_t WS_SS = 476 * MiB;
constexpr size_t WS_END = 490 * MiB;
static_assert(WS_WOUT1 + 2 * MiB <= WS_A, "ws map");

typedef float f32x2_t __attribute__((ext_vector_type(2))); typedef __bf16 bf16x2_t __attribute__((ext_vector_type(2)));
__device__ __forceinline__ unsigned cvtpk(float lo, float hi) { f32x2_t v = {lo, hi}; bf16x2_t b = __builtin_convertvector(v, bf16x2_t); return __builtin_bit_cast(unsigned, b); }
__device__ __forceinline__ float bf2f(bf16_t b) { return __uint_as_float((unsigned)b << 16); }
__device__ __forceinline__ float bflo(unsigned w) { return __uint_as_float(w << 16); }
__device__ __forceinline__ float bfhi(unsigned w) { return __uint_as_float(w & 0xffff0000u); }
__device__ __forceinline__ bf16_t f2bf(float f) { return (bf16_t)(cvtpk(f, 0.f) & 0xffffu); }
__device__ __forceinline__ int crow(int r, int hi) { return (r & 3) + 8 * (r >> 2) + 4 * hi; }
__device__ __forceinline__ s16x4 vtr(const LAS unsigned char* p) { return __builtin_bit_cast(s16x4, __builtin_amdgcn_ds_read_tr16_b64_v4i16((LAS v4i16_t*)p)); }
__device__ __forceinline__ bf16x8 cat8(s16x4 a, s16x4 b) { return (bf16x8){a[0], a[1], a[2], a[3], b[0], b[1], b[2], b[3]}; }
__device__ __forceinline__ float wave_sum(float v) {
#pragma unroll
    for (int o = 1; o < 64; o <<= 1) v += __shfl_xor(v, o);
    return v;
}
__device__ __forceinline__ float silu_f(float g) { return g * __builtin_amdgcn_rcpf(1.f + __expf(-g)); }
__device__ __forceinline__ void sincos_rev(float ang, float& sn, float& cs) {
    const double rev = (double)ang * 0.15915494309189535; const float fr = (float)(rev - floor(rev));
    sn = __builtin_amdgcn_sinf(fr); cs = __builtin_amdgcn_cosf(fr);
}
__device__ __forceinline__ float logsig(float z) { return fminf(z, 0.f) - log1pf(expf(-fabsf(z))); }

__device__ __forceinline__ void rows_rs(const float* SS, int row0, int fq, float (&rsv)[2][4]) {
    f32x4 p[2][4];
#pragma unroll
    for (int ai = 0; ai < 2; ++ai)
#pragma unroll
        for (int m = 0; m < 4; ++m) p[ai][m] = *(const GA1 f32x4*)(SS + (size_t)(row0 + ai * 128 + m * 16) * 16 + fq * 4);
#pragma unroll
    for (int ai = 0; ai < 2; ++ai)
#pragma unroll
        for (int m = 0; m < 4; ++m) { float s = (p[ai][m][0] + p[ai][m][1]) + (p[ai][m][2] + p[ai][m][3]); s += __shfl_xor(s, 16); s += __shfl_xor(s, 32); rsv[ai][m] = rsqrtf(s * (1.f / D) + EPS); }
}
struct EpiSwiglu {
    static constexpr bool PERM = true, AFTER_DRAIN = false;
    bf16_t* O; const float* SS;
    __device__ __forceinline__ void operator()(const f32x4 (&acc)[2][2][4][2], const pg8::Unit& u, int wr, int wc, int fr, int fq) const {
        const int row0 = u.pm * 256 + wr * 64 + fr, f0 = u.pn * 128 + wc * 32 + 8 * fq;
        float rsv[2][4]; rows_rs(SS, row0, fq, rsv);
#pragma unroll
        for (int ai = 0; ai < 2; ++ai)
#pragma unroll
            for (int m = 0; m < 4; ++m) {
                const int row = row0 + ai * 128 + m * 16;
                const float rs = rsv[ai][m];
                bf16_t* p = O + (size_t)row * FF + f0;
                const f32x4 g0 = acc[ai][0][m][0] * rs, g1 = acc[ai][0][m][1] * rs, u0 = acc[ai][1][m][0] * rs, u1 = acc[ai][1][m][1] * rs;
                u32x4 w;
                w.x = cvtpk(silu_f(g0[0]) * u0[0], silu_f(g0[1]) * u0[1]); w.y = cvtpk(silu_f(g0[2]) * u0[2], silu_f(g0[3]) * u0[3]);
                w.z = cvtpk(silu_f(g1[0]) * u1[0], silu_f(g1[1]) * u1[1]); w.w = cvtpk(silu_f(g1[2]) * u1[2], silu_f(g1[3]) * u1[3]);
                *(GA1 u32x4*)p = w;
            }
    }
};
struct EpiRes {
    static constexpr bool PERM = true, AFTER_DRAIN = false;
    const bf16_t* XB; bf16_t* XW; float alpha; float* SSo;
    __device__ __forceinline__ void operator()(const f32x4 (&acc)[2][2][4][2], const pg8::Unit& u, int wr, int wc, int fr, int fq) const {
        const int row0 = u.pm * 256 + wr * 64 + fr, col0 = u.pn * 256 + wc * 32 + 8 * fq;
        const bf16_t* XB = this->XB; bf16_t* XW = this->XW; float alpha = this->alpha; float* SSo = this->SSo;
        asm volatile("" : "+s"(XB), "+s"(XW), "+s"(alpha), "+s"(SSo));
        const GA1 unsigned char* xbb = (const GA1 unsigned char*)XB; GA1 unsigned char* xwb = (GA1 unsigned char*)XW;
        const unsigned off0 = (unsigned)(row0 * D + col0) * 2u;
        u32x4 bsa[2][4][2];
#pragma unroll
        for (int ai = 0; ai < 2; ++ai)
#pragma unroll
            for (int m = 0; m < 4; ++m)
#pragma unroll
                for (int bj = 0; bj < 2; ++bj) bsa[ai][m][bj] = *(const GA1 u32x4*)(xbb + (off0 + (unsigned)((ai * 128 + m * 16) * D + bj * 128) * 2u));
#pragma unroll
        for (int ai = 0; ai < 2; ++ai) {
#pragma unroll
            for (int m = 0; m < 4; ++m) {
                const int row = row0 + ai * 128 + m * 16;
                float ss = 0.f;
#pragma unroll
                for (int bj = 0; bj < 2; ++bj) { const unsigned o = off0 + (unsigned)((ai * 128 + m * 16) * D + bj * 128) * 2u; const u32x4 b = bsa[ai][m][bj];
                    const f32x4 v0 = (f32x4){bflo(b.x), bfhi(b.x), bflo(b.y), bfhi(b.y)} + alpha * acc[ai][bj][m][0], v1 = (f32x4){bflo(b.z), bfhi(b.z), bflo(b.w), bfhi(b.w)} + alpha * acc[ai][bj][m][1];
                    u32x4 w; w.x = cvtpk(v0[0], v0[1]); w.y = cvtpk(v0[2], v0[3]); w.z = cvtpk(v1[0], v1[1]); w.w = cvtpk(v1[2], v1[3]); *(GA1 u32x4*)(xwb + o) = w;
                    ss += ((v0[0] * v0[0] + v0[1] * v0[1]) + (v0[2] * v0[2] + v0[3] * v0[3])) + ((v1[0] * v1[0] + v1[1] * v1[1]) + (v1[2] * v1[2] + v1[3] * v1[3])); }
                ss += __shfl_xor(ss, 16); ss += __shfl_xor(ss, 32); if (fq == 0) *(GA1 float*)(SSo + (size_t)row * 16 + u.pn * 4 + wc) = ss;
            }
        }
    }
};
struct EpiProj {
    static constexpr bool PERM = true, AFTER_DRAIN = false;
    bf16_t* O; float* LR; const float* SS;
    __device__ __forceinline__ void operator()(const f32x4 (&acc)[2][2][4][2], const pg8::Unit& u, int wr, int wc, int fr, int fq) const {
        const int row0 = u.pm * 256 + wr * 64 + fr;
        float rsv[2][4]; rows_rs(SS, row0, fq, rsv);
        if (u.pn >= 12) {
            if (wc == 0) {
#pragma unroll
                for (int ai = 0; ai < 2; ++ai)
#pragma unroll
                    for (int m = 0; m < 4; ++m) { const int row = row0 + ai * 128 + m * 16; const float rs = rsv[ai][m];
                        float* p = LR + (size_t)row * 32 + 8 * fq; *(GA1 f32x4*)p = acc[ai][0][m][0] * rs; *(GA1 f32x4*)(p + 4) = acc[ai][0][m][1] * rs; }
            }
            return;
        }
        const int col0 = u.pn * 256 + wc * 32 + 8 * fq;
#pragma unroll
        for (int ai = 0; ai < 2; ++ai)
#pragma unroll
            for (int m = 0; m < 4; ++m) {
                const int row = row0 + ai * 128 + m * 16; const float rs = rsv[ai][m];
                bf16_t* p = O + (size_t)row * PP + col0;
#pragma unroll
                for (int bj = 0; bj < 2; ++bj) { const f32x4 v0 = acc[ai][bj][m][0] * rs, v1 = acc[ai][bj][m][1] * rs; u32x4 w; w.x = cvtpk(v0[0], v0[1]); w.y = cvtpk(v0[2], v0[3]); w.z = cvtpk(v1[0], v1[1]); w.w = cvtpk(v1[2], v1[3]); *(GA1 u32x4*)(p + bj * 128) = w; }
            }
    }
};

__device__ __forceinline__ void tr_item(const float* W, int K, int N, bf16_t* WT, int mode, float sc, int sc_lo, int sc_hi, const float* gain, LAS float* scr, int item, int lane) {
    const int nblk = N / 32, kb = item / nblk, nb = item % nblk, k0 = 64 * kb, n0 = 32 * nb;
#pragma unroll 8
    for (int i = 0; i < 32; ++i) { const int kk = 2 * i + (lane >> 5); scr[kk * 33 + (lane & 31)] = W[(size_t)(k0 + kk) * N + n0 + (lane & 31)]; }
    asm volatile("s_waitcnt lgkmcnt(0)" ::: "memory");
    const int d0 = mode ? (256 * (n0 >> 7) + (n0 & 127) + (mode == 2 ? 128 : 0)) : n0;
    const float s = (n0 >= sc_lo && n0 < sc_hi) ? sc : 1.f;
    const int c = lane & 7;
    f32x4 ga = {s, s, s, s}, gb = {s, s, s, s};
    if (gain) { ga = ga * *(const GA1 f32x4*)(gain + k0 + 8 * c); gb = gb * *(const GA1 f32x4*)(gain + k0 + 8 * c + 4); }
#pragma unroll
    for (int j = 0; j < 4; ++j) { const int n = (lane >> 3) + 8 * j; const LAS float* p = scr + (8 * c) * 33 + n;
        u32x4 o; o.x = cvtpk(p[0 * 33] * ga[0], p[1 * 33] * ga[1]); o.y = cvtpk(p[2 * 33] * ga[2], p[3 * 33] * ga[3]); o.z = cvtpk(p[4 * 33] * gb[0], p[5 * 33] * gb[1]); o.w = cvtpk(p[6 * 33] * gb[2], p[7 * 33] * gb[3]);
        *(GA1 u32x4*)(WT + (size_t)(d0 + n) * K + k0 + 8 * c) = o; }
    asm volatile("s_waitcnt lgkmcnt(0)" ::: "memory");
}

template <bool OUT_F32>
__device__ __forceinline__ void norm_phase(const float* src, const float* gain, bf16_t* dst, float* dstf, int gw, int NGW, int lane) {
    f32x4 g[4];
#pragma unroll
    for (int j = 0; j < 4; ++j) g[j] = ((const f32x4*)gain)[lane + 64 * j];
    for (int m0 = gw; m0 < T; m0 += 4 * NGW) {
        f32x4 v[4][4]; float ss[4];
#pragma unroll
        for (int q = 0; q < 4; ++q) { const int m = m0 + q * NGW; const GA1 f32x4* xr = (const GA1 f32x4*)(src + (size_t)(m < T ? m : m0) * D) + lane;
#pragma unroll
            for (int j = 0; j < 4; ++j) v[q][j] = xr[64 * j]; }
#pragma unroll
        for (int q = 0; q < 4; ++q) { float a = 0.f;
#pragma unroll
            for (int j = 0; j < 4; ++j) a += (v[q][j].x * v[q][j].x + v[q][j].y * v[q][j].y) + (v[q][j].z * v[q][j].z + v[q][j].w * v[q][j].w);
            ss[q] = a; }
#pragma unroll
        for (int o = 1; o < 64; o <<= 1)
#pragma unroll
            for (int q = 0; q < 4; ++q) ss[q] += __shfl_xor(ss[q], o);
#pragma unroll
        for (int q = 0; q < 4; ++q) { const int m = m0 + q * NGW; if (m >= T) break;
            const float r = rsqrtf(ss[q] * (1.f / D) + EPS);
            if (OUT_F32) { GA1 f32x4* o = (GA1 f32x4*)(dstf + (size_t)m * D) + lane;
#pragma unroll
                for (int j = 0; j < 4; ++j) o[64 * j] = v[q][j] * r * g[j];
            } else { GA1 u32x2* o = (GA1 u32x2*)(dst + (size_t)m * D) + lane;
#pragma unroll
                for (int j = 0; j < 4; ++j) { const f32x4 y = v[q][j] * r * g[j]; u32x2 w; w.x = cvtpk(y.x, y.y); w.y = cvtpk(y.z, y.w); o[64 * j] = w; } }
        }
    }
}

__device__ __forceinline__ void final_phase(const bf16_t* src, const float* SS, const float* gain, float* dstf, int gw, int NGW, int lane) {
    f32x4 g[4];
#pragma unroll
    for (int j = 0; j < 4; ++j) g[j] = ((const f32x4*)gain)[lane * 4 + j];
    for (int m0 = gw; m0 < T; m0 += 8 * NGW) {
        u32x4 v[8][2]; float pr[8];
#pragma unroll
        for (int q = 0; q < 8; ++q) { const int m = (m0 + q * NGW) < T ? (m0 + q * NGW) : m0; const GA1 u32x4* xr = (const GA1 u32x4*)(src + (size_t)m * D + lane * 16); v[q][0] = xr[0]; v[q][1] = xr[1];
            pr[q] = *(const GA1 float*)(SS + (size_t)m * 16 + (lane & 15)); }
#pragma unroll
        for (int q = 0; q < 8; ++q) { float a = pr[q]; a += __shfl_xor(a, 1); a += __shfl_xor(a, 2); a += __shfl_xor(a, 4); a += __shfl_xor(a, 8); pr[q] = rsqrtf(a * (1.f / D) + EPS); }
#pragma unroll
        for (int q = 0; q < 8; ++q) { const int m = m0 + q * NGW; if (m >= T) break;
            GA1 f32x4* o = (GA1 f32x4*)(dstf + (size_t)m * D + lane * 16); const float r = pr[q];
#pragma unroll
            for (int c = 0; c < 2; ++c) { const u32x4 b = v[q][c];
                o[2 * c] = (f32x4){bflo(b.x), bfhi(b.x), bflo(b.y), bfhi(b.y)} * r * g[2 * c]; o[2 * c + 1] = (f32x4){bflo(b.z), bfhi(b.z), bflo(b.w), bfhi(b.w)} * r * g[2 * c + 1]; }
        }
    }
}

__device__ __forceinline__ void cast_phase(const float* src, bf16_t* dst, float* SSo, int gw, int NGW, int lane) {
    for (int m0 = gw; m0 < T; m0 += 8 * NGW) {
        f32x4 v[8][4]; float ss[8];
#pragma unroll
        for (int q = 0; q < 8; ++q) { const int m = m0 + q * NGW; const GA1 f32x4* xr = (const GA1 f32x4*)(src + (size_t)(m < T ? m : m0) * D) + lane;
#pragma unroll
            for (int j = 0; j < 4; ++j) v[q][j] = xr[64 * j]; }
#pragma unroll
        for (int q = 0; q < 8; ++q) { float a = 0.f;
#pragma unroll
            for (int j = 0; j < 4; ++j) a += (v[q][j].x * v[q][j].x + v[q][j].y * v[q][j].y) + (v[q][j].z * v[q][j].z + v[q][j].w * v[q][j].w);
            ss[q] = a; }
#pragma unroll
        for (int o = 1; o < 64; o <<= 1)
#pragma unroll
            for (int q = 0; q < 8; ++q) ss[q] += __shfl_xor(ss[q], o);
#pragma unroll
        for (int q = 0; q < 8; ++q) { const int m = m0 + q * NGW; if (m >= T) break;
            GA1 u32x2* o = (GA1 u32x2*)(dst + (size_t)m * D) + lane;
#pragma unroll
            for (int j = 0; j < 4; ++j) { u32x2 w; w.x = cvtpk(v[q][j].x, v[q][j].y); w.y = cvtpk(v[q][j].z, v[q][j].w); o[64 * j] = w; }
            if (lane < 16) *(GA1 float*)(SSo + (size_t)m * 16 + lane) = lane == 0 ? ss[q] : 0.f; }
    }
}

__device__ __forceinline__ void prep0_phase(bf16_t* P, const int* pos, const float* logit_f, const float* logit_b, bf16_t* QGf, bf16_t* KGf, bf16_t* QGb, bf16_t* KGb,
                                            float* DECf, float* DECb, int gw, int NGW, int lane) {
    const int fa = lane & 7, fr_ = lane & 31, hh = lane >> 5;
    const float inva = exp2f(-18.931568569324174f * (float)(2 * fa) * (1.f / 16.f));
    const float invr = exp2f(-13.287712379549449f * (float)(2 * fr_) * (1.f / 64.f));
    float lgf[4], lgb[4];
#pragma unroll
    for (int h = 0; h < 4; ++h) { lgf[h] = logsig(logit_f[h]); lgb[h] = logsig(logit_b[h]); }
    for (int m = gw; m < T; m += NGW) {
        const int b = m >> 12, s = m & 4095, c = s & 63;
        const float posf = (float)pos[s];
        bf16_t* row = P + (size_t)m * PP;
        unsigned short ar[2][2], rr[4][2];
#pragma unroll
        for (int i = 0; i < 2; ++i) { const int col = i * 512 + (lane >> 3) * 64 + fa; ar[i][0] = *(const GA1 bf16_t*)(row + col); ar[i][1] = *(const GA1 bf16_t*)(row + col + 8); }
#pragma unroll
        for (int i = 0; i < 4; ++i) { const int which = i >> 1, head = ((i & 1) << 1) | hh, col = 1536 + which * 256 + head * 64 + fr_; rr[i][0] = *(const GA1 bf16_t*)(row + col); rr[i][1] = *(const GA1 bf16_t*)(row + col + 32); }
        {
            float sn, cs; sincos_rev(posf * inva, sn, cs);
#pragma unroll
            for (int i = 0; i < 2; ++i) { const int col = i * 512 + (lane >> 3) * 64 + fa; const float x1 = bf2f(ar[i][0]), x2 = bf2f(ar[i][1]);
                *(GA1 bf16_t*)(row + col) = f2bf(x1 * cs - x2 * sn); *(GA1 bf16_t*)(row + col + 8) = f2bf(x1 * sn + x2 * cs); }
        }
        {
            float sn, cs; sincos_rev(posf * invr, sn, cs);
#pragma unroll
            for (int i = 0; i < 4; ++i) {
                const int which = i >> 1, head = ((i & 1) << 1) | hh;
                const float lf = hh ? lgf[((i & 1) << 1) | 1] : lgf[(i & 1) << 1], lb = hh ? lgb[((i & 1) << 1) | 1] : lgb[(i & 1) << 1];
                const float x1 = bf2f(rr[i][0]), x2 = bf2f(rr[i][1]);
                const float ksc = which ? 0.125f : 1.f;
                const float y1 = (x1 * cs - x2 * sn) * ksc, y2 = (x1 * sn + x2 * cs) * ksc;
                float ef = lf * (float)(c + 1), eb = lb * (float)(64 - c);
                if (which) { ef = -ef; eb = -eb; }
                const float gf = expf(ef), gb = expf(eb);
                const size_t o = (size_t)m * 256 + head * 64 + fr_;
                bf16_t* df = which ? KGf : QGf; bf16_t* db = which ? KGb : QGb;
                *(GA1 bf16_t*)(df + o) = f2bf(y1 * gf); *(GA1 bf16_t*)(df + o + 32) = f2bf(y2 * gf); *(GA1 bf16_t*)(db + o) = f2bf(y1 * gb); *(GA1 bf16_t*)(db + o + 32) = f2bf(y2 * gb);
            }
        }
        if (c == 0) {
            const int n = s >> 6;
#pragma unroll
            for (int e8 = 0; e8 < 8; ++e8) { const int e = lane + 64 * e8, dir = e >> 8, hd = (e >> 6) & 3, d = e & 63;
                const float lg = dir ? (hd == 0 ? lgb[0] : hd == 1 ? lgb[1] : hd == 2 ? lgb[2] : lgb[3]) : (hd == 0 ? lgf[0] : hd == 1 ? lgf[1] : hd == 2 ? lgf[2] : lgf[3]);
                (dir ? DECb : DECf)[((size_t)(b * 4 + hd) * 64 + n) * 64 + d] = expf(lg * 64.f); }
        }
    }
}

__device__ __forceinline__ void prep1_phase(const bf16_t* P, const float* LR, const float* w2f, const float* bf_, const float* w2b, const float* bb_, bf16_t* QGf, bf16_t* KGf, bf16_t* QGb, bf16_t* KGb,
                                            float* DECf, float* DECb, int tid, LAS unsigned char* lds, int bid, int G) {
    const int ch = tid & 127, tg = __builtin_amdgcn_readfirstlane(tid >> 7);
    LAS float* tot = (LAS float*)lds;
    LAS float* lrs = (LAS float*)(lds + 4096);
    typedef float f32x2v __attribute__((ext_vector_type(2)));
    f32x2v lrv; unsigned short qraw[16], kraw[16];
    float wcol[16]; float bias = 0.f; int key = -1;
#define P1_LOADS(IT, LV, QR, KR) do { const int dir_ = (IT) & 1, h_ = ((IT) >> 1) & 3, chunk_ = ((IT) >> 3) & 63, b_ = (IT) >> 9; const size_t tb_ = (size_t)b_ * SEQ + chunk_ * 64; \
        LV = *(const GA1 f32x2v*)(LR + (tb_ + (tid >> 3)) * 32 + dir_ * 16 + (tid & 7) * 2); \
        _Pragma("unroll") for (int i_ = 0; i_ < 16; ++i_) { QR[i_] = *(const GA1 bf16_t*)(P + (tb_ + tg * 16 + i_) * PP + h_ * 128 + ch); KR[i_] = *(const GA1 bf16_t*)(P + (tb_ + tg * 16 + i_) * PP + 512 + h_ * 128 + ch); } } while (0)
    if (bid < 4096) P1_LOADS(bid, lrv, qraw, kraw);
#pragma unroll 1
    for (int it = bid; it < 4096; it += G) {
        const int dir = it & 1, h = (it >> 1) & 3, chunk = (it >> 3) & 63, b = it >> 9;
        if ((it & 7) != key) {
            const float* w2 = dir ? w2b : w2f;
#pragma unroll
            for (int r = 0; r < 16; ++r) wcol[r] = *(const GA1 float*)(w2 + r * 512 + h * 128 + ch);
            bias = *(const GA1 float*)((dir ? bb_ : bf_) + h * 128 + ch); key = it & 7;
        }
        bf16_t* QG = dir ? QGb : QGf; bf16_t* KG = dir ? KGb : KGf;
        const size_t t0 = (size_t)b * SEQ + chunk * 64 + tg * 16;
        *(LAS f32x2v*)(lrs + (tid >> 3) * 16 + (tid & 7) * 2) = lrv;
        __syncthreads();
        f32x2v nlrv = lrv; unsigned short nq[16], nk[16];
#pragma unroll
        for (int i = 0; i < 16; ++i) { nq[i] = qraw[i]; nk[i] = kraw[i]; }
        if (it + G < 4096) P1_LOADS(it + G, nlrv, nq, nk);
        float cum[16];
#pragma unroll
        for (int i = 0; i < 16; ++i) {
            const LAS f32x4* lr = (const LAS f32x4*)(lrs + (tg * 16 + i) * 16);
            const f32x4 l0 = lr[0], l1 = lr[1], l2 = lr[2], l3 = lr[3];
            float z = bias;
            z += l0[0] * wcol[0] + l0[1] * wcol[1] + l0[2] * wcol[2] + l0[3] * wcol[3];
            z += l1[0] * wcol[4] + l1[1] * wcol[5] + l1[2] * wcol[6] + l1[3] * wcol[7];
            z += l2[0] * wcol[8] + l2[1] * wcol[9] + l2[2] * wcol[10] + l2[3] * wcol[11];
            z += l3[0] * wcol[12] + l3[1] * wcol[13] + l3[2] * wcol[14] + l3[3] * wcol[15];
            { const float e = __builtin_amdgcn_exp2f(-fabsf(z) * 1.4426950408889634f);
              cum[i] = (fminf(z, 0.f) * 1.4426950408889634f - __builtin_amdgcn_logf(1.f + e)) * (1.f / 16.f); }
        }
        float total;
        if (!dir) {
#pragma unroll
            for (int i = 1; i < 16; ++i) cum[i] += cum[i - 1];
            total = cum[15];
        } else {
#pragma unroll
            for (int i = 14; i >= 0; --i) cum[i] += cum[i + 1];
            total = cum[0];
        }
        tot[tg * 128 + ch] = total;
        __syncthreads();
        const float s0 = tot[ch], s1 = tot[128 + ch], s2 = tot[256 + ch], s3 = tot[384 + ch];
        float off;
        if (!dir) off = tg == 0 ? 0.f : tg == 1 ? s0 : tg == 2 ? s0 + s1 : (s0 + s1) + s2;
        else off = tg == 3 ? 0.f : tg == 2 ? s3 : tg == 1 ? s3 + s2 : (s3 + s2) + s1;
#pragma unroll
        for (int i = 0; i < 16; ++i) {
            const float c = cum[i] + off;
            const float qv = bf2f(qraw[i]), kv = bf2f(kraw[i]);
            *(GA1 bf16_t*)(QG + (t0 + i) * 512 + h * 128 + ch) = f2bf(qv * __builtin_amdgcn_exp2f(c));
            *(GA1 bf16_t*)(KG + (t0 + i) * 512 + h * 128 + ch) = f2bf(kv * __builtin_amdgcn_exp2f(-c));
        }
        if (tg == 0) *(GA1 float*)((dir ? DECb : DECf) + ((size_t)(b * 4 + h) * 64 + chunk) * 128 + ch) = __builtin_amdgcn_exp2f((s0 + s1) + (s2 + s3));
        lrv = nlrv;
#pragma unroll
        for (int i = 0; i < 16; ++i) { qraw[i] = nq[i]; kraw[i] = nk[i]; }
    }
#undef P1_LOADS
}
#define XB_TMO      128
#define XB_XCNT(j)  (256  + 64 * (j))
#define XB_XSUB(j)  (1280 + 64 * (j))
#define XB_XGEN(j)  (2304 + 64 * (j))
#define XB_TOP      3328
#define XB_TOPGEN   3392
#define XCD_BAR_WORDS 3456
#define XB_SPIN_CAP (1u << 18)

__device__ __forceinline__ unsigned xb_ld(unsigned* p)              { return __hip_atomic_load(p, __ATOMIC_RELAXED, __HIP_MEMORY_SCOPE_AGENT); }
__device__ __forceinline__ unsigned xb_add(unsigned* p, unsigned v) { return __hip_atomic_fetch_add(p, v, __ATOMIC_RELAXED, __HIP_MEMORY_SCOPE_AGENT); }
__device__ __forceinline__ unsigned xb_xcc_id() { return (unsigned)__builtin_amdgcn_s_getreg((3 << 11) | 20) & 0xFu; }
#define XB_SPIN(cond, bar) do { unsigned _sp = 0; while (cond) { __builtin_amdgcn_s_sleep(1); \
    if ((++_sp & 255u) == 0u) { if (xb_ld(&(bar)[XB_TMO])) break; if (_sp > XB_SPIN_CAP) { atomicAdd(&(bar)[XB_TMO], 1u); break; } } } } while (0)

struct XcdBarrier {
    unsigned* bar; unsigned x;
    volatile LAS unsigned* st;
};

__device__ __forceinline__ XcdBarrier xcd_barrier_post(unsigned* bar, volatile LAS unsigned* st) {
    XcdBarrier b; b.bar = bar; b.x = xb_xcc_id(); b.st = st;
    if (threadIdx.x == 0) (void)xb_add(&bar[XB_XCNT(b.x)], 1u);
    return b;
}
__device__ __forceinline__ void xcd_barrier_complete(unsigned* bar, unsigned x, unsigned& nloc, unsigned& nx) {
    const unsigned G = gridDim.x * gridDim.y * gridDim.z;
    unsigned sum, cnt, mine, sp = 0u;
    for (;;) {
        sum = 0u; cnt = 0u; mine = 0u;
#pragma unroll
        for (unsigned j = 0; j < 16; ++j) { const unsigned c = xb_ld(&bar[XB_XCNT(j)]); sum += c; cnt += (c > 0u) ? 1u : 0u; mine = (j == x) ? c : mine; }
        if (sum == G) break;
        __builtin_amdgcn_s_sleep(1);
        if ((++sp & 255u) == 0u) { if (xb_ld(&bar[XB_TMO])) break; if (sp > XB_SPIN_CAP) { atomicAdd(&bar[XB_TMO], 1u); break; } }
    }
    nloc = mine > 0u ? mine : 1u; nx = cnt > 0u ? cnt : 1u;
}

__device__ __forceinline__ void xcd_barrier(const XcdBarrier& b) {
    asm volatile("s_waitcnt vmcnt(0)" ::: "memory");
    __syncthreads();
    if (threadIdx.x == 0) {
        unsigned* bar = b.bar;
        __builtin_amdgcn_s_waitcnt(0);
        unsigned nloc = b.st[0], nx = b.st[1];
        if (nloc == 0u) { xcd_barrier_complete(bar, b.x, nloc, nx); b.st[0] = nloc; b.st[1] = nx; }
        const unsigned old = xb_add(&bar[XB_XSUB(b.x)], 1u);
        const unsigned gen = old / nloc;
        if (old + 1u == (gen + 1u) * nloc) {
            __builtin_amdgcn_fence(__ATOMIC_RELEASE, "agent");
            asm volatile("s_waitcnt vmcnt(0)" ::: "memory");
            const unsigned og = xb_add(&bar[XB_TOP], 1u);
            const unsigned tg = og / nx;
            if (og + 1u == (tg + 1u) * nx) xb_add(&bar[XB_TOPGEN], 1u);
            else XB_SPIN(xb_ld(&bar[XB_TOPGEN]) == tg, bar);
            __builtin_amdgcn_fence(__ATOMIC_ACQUIRE, "agent");
            xb_add(&bar[XB_XGEN(b.x)], 1u);
            asm volatile("s_waitcnt vmcnt(0)" ::: "memory");
        } else {
            XB_SPIN(xb_ld(&bar[XB_XGEN(b.x)]) == gen, bar);
            __builtin_amdgcn_fence(__ATOMIC_ACQUIRE, "agent");
            asm volatile("s_waitcnt vmcnt(0)" ::: "memory");
        }
    }
    __syncthreads();
}
#ifndef AT_VALU_MASK
#define AT_VALU_MASK 0x002
#endif
constexpr int AT_KP = 272, AT_VP = 320, AT_KB = 64 * AT_KP, AT_VB = 64 * AT_VP, AT_TB = AT_KB + AT_VB;
__device__ __forceinline__ void attn_unit(LAS unsigned char* lds, const bf16_t* P, bf16_t* cat, int b, int h, int qb, float lam, const float* da_norm, float post_scale) {
    int tid_ = threadIdx.x; asm volatile("" : "+v"(tid_)); const int tid = tid_, lane = tid & 63, w = __builtin_amdgcn_readfirstlane(tid >> 6), r32 = lane & 31, hi = lane >> 5;
    const int comp = w >> 2, qs = w & 3, i16 = lane & 15, qq = i16 >> 2, pp = i16 & 3, blk = (lane >> 4) & 1;
    const size_t rowb = (size_t)b * SEQ;
    const bf16_t* qp = P + (rowb + qb * 128 + qs * 32 + r32) * PP + h * 128 + comp * 64 + hi * 8;
    LAS unsigned char* Qs = lds + 2 * AT_KB + 2 * AT_VB + (w * 4 * 64 + lane) * 16;
#pragma unroll
    for (int s = 0; s < 4; ++s) *(LAS bf16x8*)(Qs + s * 1024) = *(const GA1 bf16x8*)(qp + 16 * s);
    const int srow = tid >> 4, sch = tid & 15;
    const bf16_t* kg = P + (rowb + srow) * PP + 512 + h * 128 + sch * 8;
    const bf16_t* vg = P + (rowb + srow) * PP + 1024 + h * 128 + sch * 8;
    u32x4 kr0, kr1, vr0, vr1;
#define AT_LOADK(t) do { const size_t o_ = (size_t)(t) * 64 * PP; kr0 = *(const GA1 u32x4*)(kg + o_); kr1 = *(const GA1 u32x4*)(kg + o_ + 32 * PP); } while (0)
#define AT_LOADV(t) do { const size_t o_ = (size_t)(t) * 64 * PP; vr0 = *(const GA1 u32x4*)(vg + o_); vr1 = *(const GA1 u32x4*)(vg + o_ + 32 * PP); } while (0)
#define AT_STOREK(bufi) do { LAS unsigned char* kb_ = lds + (bufi) * AT_KB; *(LAS u32x4*)(kb_ + srow * AT_KP + sch * 16) = kr0; *(LAS u32x4*)(kb_ + (srow + 32) * AT_KP + sch * 16) = kr1; } while (0)
#define AT_STOREV(bufi) do { LAS unsigned char* vb_ = lds + 2 * AT_KB + (bufi) * AT_VB; *(LAS u32x4*)(vb_ + srow * AT_VP + sch * 16) = vr0; *(LAS u32x4*)(vb_ + (srow + 32) * AT_VP + sch * 16) = vr1; } while (0)
#define AT_QK(bufi) do { const LAS unsigned char* Kc = lds + (bufi) * AT_KB; bf16x8 ka[4], kb_[4]; \
        _Pragma("unroll") for (int s = 0; s < 4; ++s) { ka[s] = *(const LAS bf16x8*)(Kc + r32 * AT_KP + comp * 128 + s * 32 + hi * 16); kb_[s] = *(const LAS bf16x8*)(Kc + (32 + r32) * AT_KP + comp * 128 + s * 32 + hi * 16); } \
        _Pragma("unroll") for (int r_ = 0; r_ < 16; ++r_) { s0[r_] = nmh; s1[r_] = nmh; } \
        _Pragma("unroll") for (int s = 0; s < 4; ++s) { const bf16x8 qv_ = *(const LAS bf16x8*)(Qs + s * 1024); s0 = __builtin_amdgcn_mfma_f32_32x32x16_bf16(ka[s], qv_, s0, 0, 0, 0); s1 = __builtin_amdgcn_mfma_f32_32x32x16_bf16(kb_[s], qv_, s1, 0, 0, 0); } } while (0)
#define AT_PV(bufi) do { const LAS unsigned char* vb0 = lds + 2 * AT_KB + (bufi) * AT_VB + (4 * hi + qq) * AT_VP + (16 * blk + 4 * pp) * 2; \
        _Pragma("unroll") for (int vb = 0; vb < 4; ++vb) { s16x4 vf_[8]; \
            _Pragma("unroll") for (int kb = 0; kb < 2; ++kb) _Pragma("unroll") for (int s2 = 0; s2 < 2; ++s2) { const LAS unsigned char* ad = vb0 + (kb * 32 + 16 * s2) * AT_VP + vb * 64; vf_[(kb * 2 + s2) * 2] = vtr(ad); vf_[(kb * 2 + s2) * 2 + 1] = vtr(ad + 8 * AT_VP); } \
            __builtin_amdgcn_sched_barrier(0); \
            _Pragma("unroll") for (int kb = 0; kb < 2; ++kb) _Pragma("unroll") for (int s2 = 0; s2 < 2; ++s2) \
                o[vb] = __builtin_amdgcn_mfma_f32_32x32x16_bf16(cat8(vf_[(kb * 2 + s2) * 2], vf_[(kb * 2 + s2) * 2 + 1]), __builtin_bit_cast(bf16x8, pw[kb][s2]), o[vb], 0, 0, 0); \
            __builtin_amdgcn_sched_barrier(0); } } while (0)
#define AT_PACK(dst) do { _Pragma("unroll") for (int s2 = 0; s2 < 2; ++s2) { \
            dst[0][s2] = (u32x4){cvtpk(s0[8 * s2 + 0], s0[8 * s2 + 1]), cvtpk(s0[8 * s2 + 2], s0[8 * s2 + 3]), cvtpk(s0[8 * s2 + 4], s0[8 * s2 + 5]), cvtpk(s0[8 * s2 + 6], s0[8 * s2 + 7])}; \
            dst[1][s2] = (u32x4){cvtpk(s1[8 * s2 + 0], s1[8 * s2 + 1]), cvtpk(s1[8 * s2 + 2], s1[8 * s2 + 3]), cvtpk(s1[8 * s2 + 4], s1[8 * s2 + 5]), cvtpk(s1[8 * s2 + 6], s1[8 * s2 + 7])}; } } while (0)
    if (w >= 4) __builtin_amdgcn_s_setprio(1);
    {
        const u32x4 k1a = *(const GA1 u32x4*)(kg + (size_t)64 * PP), k1b = *(const GA1 u32x4*)(kg + (size_t)64 * PP + 32 * PP);
        AT_LOADK(0); AT_LOADV(0); AT_STOREK(0); AT_STOREV(0);
        kr0 = k1a; kr1 = k1b; AT_STOREK(1);
    }
    __syncthreads();
    f32x16 o[4];
#pragma unroll
    for (int v = 0; v < 4; ++v)
#pragma unroll
        for (int r = 0; r < 16; ++r) o[v][r] = 0.f;
    float mhat = 0.f, l_run = 0.f, nmh = 0.f;
    f32x16 s0, s1;
    u32x4 pw[2][2];
    {
        AT_QK(0);
        float mx = fmaxf(fmaxf(s0[0], s1[0]), fmaxf(s0[1], s1[1]));
#pragma unroll
        for (int r = 2; r < 16; r += 2) mx = fmaxf(fmaxf(mx, fmaxf(s0[r], s1[r])), fmaxf(s0[r + 1], s1[r + 1]));
        mx = fmaxf(mx, __shfl_xor(mx, 32));
        mhat = mx;
        float psum = 0.f;
        nmh = -mhat;
#pragma unroll
        for (int r = 0; r < 16; ++r) { s0[r] = __builtin_amdgcn_exp2f(s0[r] - mx); s1[r] = __builtin_amdgcn_exp2f(s1[r] - mx); psum += s0[r] + s1[r]; }
        l_run = psum;
        AT_PACK(pw);
    }
    for (int t = 0; t < 63; ++t) {
        if (t + 2 < 64) AT_LOADK(t + 2);
        AT_LOADV(t + 1);
        AT_QK((t + 1) & 1);
        asm volatile("" : "+v"(s0), "+v"(s1) :: "memory");
        float psum = 0.f;
        u32x4 pwn[2][2];
        {
            const LAS unsigned char* vb0 = lds + 2 * AT_KB + (t & 1) * AT_VB + (4 * hi + qq) * AT_VP + (16 * blk + 4 * pp) * 2;
            s16x4 vfa[2][8];
#define AT_VRD(buf, vb) do { _Pragma("unroll") for (int kb = 0; kb < 2; ++kb) _Pragma("unroll") for (int s2 = 0; s2 < 2; ++s2) { \
                const LAS unsigned char* ad = vb0 + (kb * 32 + 16 * s2) * AT_VP + (vb) * 64; vfa[buf][(kb * 2 + s2) * 2] = vtr(ad); vfa[buf][(kb * 2 + s2) * 2 + 1] = vtr(ad + 8 * AT_VP); } } while (0)
            AT_VRD(0, 0);
#pragma unroll
            for (int vb = 0; vb < 4; ++vb) {
                if (vb < 3) AT_VRD((vb + 1) & 1, vb + 1);
                __builtin_amdgcn_sched_barrier(0);
#pragma unroll
                for (int q4 = 0; q4 < 4; ++q4) {
                    const int i = vb * 4 + q4, kb = q4 >> 1, s2 = q4 & 1;
                    o[vb] = __builtin_amdgcn_mfma_f32_32x32x16_bf16(cat8(vfa[vb & 1][(kb * 2 + s2) * 2], vfa[vb & 1][(kb * 2 + s2) * 2 + 1]), __builtin_bit_cast(bf16x8, pw[kb][s2]), o[vb], 0, 0, 0);
                    float e0, e1;
                    if (i < 8) { e0 = __builtin_amdgcn_exp2f(s0[2 * i]); e1 = __builtin_amdgcn_exp2f(s0[2 * i + 1]); s0[2 * i] = e0; s0[2 * i + 1] = e1; }
                    else { e0 = __builtin_amdgcn_exp2f(s1[2 * (i - 8)]); e1 = __builtin_amdgcn_exp2f(s1[2 * (i - 8) + 1]); s1[2 * (i - 8)] = e0; s1[2 * (i - 8) + 1] = e1; }
                    psum += e0 + e1;
                    pwn[i >> 3][(i >> 2) & 1][i & 3] = cvtpk(e0, e1);
                    asm volatile("" : "+v"(psum), "+v"(o[vb]) :: "memory");
                    __builtin_amdgcn_sched_barrier(0);
                }
            }
#undef AT_VRD
        }
        if (__any(psum > 4096.f)) {
            float pm = fmaxf(fmaxf(s0[0], s1[0]), fmaxf(s0[1], s1[1]));
#pragma unroll
            for (int r = 2; r < 16; r += 2) pm = fmaxf(fmaxf(pm, fmaxf(s0[r], s1[r])), fmaxf(s0[r + 1], s1[r + 1]));
            pm = fmaxf(pm, __shfl_xor(pm, 32));
            const float dl = fmaxf(__builtin_amdgcn_logf(pm), 0.f), f = __builtin_amdgcn_exp2f(-dl);
            mhat += dl; psum *= f; l_run *= f;
            nmh = -mhat;
#pragma unroll
            for (int r = 0; r < 16; ++r) { s0[r] *= f; s1[r] *= f; }
#pragma unroll
            for (int v = 0; v < 4; ++v)
#pragma unroll
                for (int r = 0; r < 16; ++r) o[v][r] *= f;
            AT_PACK(pwn);
        }
        l_run += psum;
#pragma unroll
        for (int a_ = 0; a_ < 2; ++a_)
#pragma unroll
            for (int b_ = 0; b_ < 2; ++b_) pw[a_][b_] = pwn[a_][b_];
        if (t + 2 < 64) AT_STOREK(t & 1);
        AT_STOREV((t + 1) & 1);
        __syncthreads();
    }
    AT_PV(1);
    __builtin_amdgcn_s_setprio(0);
    __syncthreads();
#undef AT_LOADK
#undef AT_LOADV
#undef AT_STOREK
#undef AT_STOREV
#undef AT_QK
#undef AT_PV
#undef AT_PACK
    const float l = l_run + __shfl_xor(l_run, 32), inv = 1.f / l;
    LAS float* ex = (LAS float*)lds;
    if (comp == 1) {
#pragma unroll
        for (int v = 0; v < 4; ++v)
#pragma unroll
            for (int r = 0; r < 16; ++r) ex[(v * 16 + r) * 256 + qs * 64 + lane] = o[v][r] * inv;
    }
    __syncthreads();
    if (comp == 0) {
        float ss = 0.f;
#pragma unroll
        for (int v = 0; v < 4; ++v)
#pragma unroll
            for (int r = 0; r < 16; ++r) { const float d = o[v][r] * inv - lam * ex[(v * 16 + r) * 256 + qs * 64 + lane]; o[v][r] = d; ss += d * d; }
        ss += __shfl_xor(ss, 32);
        const float rs = rsqrtf(ss * (1.f / 128.f) + EPS) * post_scale;
        bf16_t* op = cat + (rowb + qb * 128 + qs * 32 + r32) * D + h * 128;
        f32x4 gnv[4][4];
#pragma unroll
        for (int v = 0; v < 4; ++v)
#pragma unroll
            for (int g = 0; g < 4; ++g) gnv[v][g] = *(const GA1 f32x4*)(da_norm + v * 32 + 8 * g + 4 * hi);
#pragma unroll
        for (int v = 0; v < 4; ++v)
#pragma unroll
            for (int g = 0; g < 4; ++g) { const int vv = v * 32 + 8 * g + 4 * hi; const f32x4 gn = gnv[v][g];
                u32x2 wv; wv.x = cvtpk(o[v][4 * g] * rs * gn[0], o[v][4 * g + 1] * rs * gn[1]); wv.y = cvtpk(o[v][4 * g + 2] * rs * gn[2], o[v][4 * g + 3] * rs * gn[3]);
                *(GA1 u32x2*)(op + vv) = wv; }
    }
    __syncthreads();
}

#define GAS __attribute__((address_space(1)))
template <int DK>
__device__ __forceinline__ void walk_unit(LAS unsigned char* lds, const bf16_t* QG, const bf16_t* KG, int h, const bf16_t* Vp, const float* dec, bf16_t* Op, int opitch, int b, int dir) {
    constexpr int PQ = DK * 2 + 16, PV = 144, NCH = DK / 8, QB = 64 * PQ, VB = 64 * PV, TB = 2 * QB + VB, ST0 = 2 * TB, STB = 64 * PQ, NQ = 64 * NCH / 512, QPITCH = 4 * DK;
    static_assert(ST0 + 2 * STB <= 131072, "walk LDS");
    int tid_ = threadIdx.x; asm volatile("" : "+v"(tid_)); const int tid = tid_, lane = tid & 63, w = __builtin_amdgcn_readfirstlane(tid >> 6), r32 = lane & 31, hi = lane >> 5;
    const int i16 = lane & 15, qq = i16 >> 2, pp = i16 & 3, blk = (lane >> 4) & 1;
    u32x4 qreg[2][NQ], kreg[2][NQ], vreg[2];
    const int vrow = tid >> 3, vch = tid & 7;
#define WK_LOAD(set, n) do { const size_t t0_ = (size_t)b * SEQ + (size_t)(n) * 64; \
        _Pragma("unroll") for (int i_ = 0; i_ < NQ; ++i_) { const int id_ = tid + 512 * i_, row_ = id_ / NCH, ch_ = id_ % NCH; const size_t go_ = (t0_ + row_) * QPITCH + h * DK + ch_ * 8; \
            qreg[set][i_] = *(const GAS u32x4*)(QG + go_); kreg[set][i_] = *(const GAS u32x4*)(KG + go_); } \
        vreg[set] = *(const GAS u32x4*)(Vp + (t0_ + vrow) * PP + vch * 8); } while (0)
#define WK_STORE(set, bufi) do { LAS unsigned char* q_ = lds + (bufi) * TB; \
        _Pragma("unroll") for (int i_ = 0; i_ < NQ; ++i_) { const int id_ = tid + 512 * i_, row_ = id_ / NCH, ch_ = id_ % NCH; \
            *(LAS u32x4*)(q_ + row_ * PQ + ch_ * 16) = qreg[set][i_]; *(LAS u32x4*)(q_ + QB + row_ * PQ + ch_ * 16) = kreg[set][i_]; } \
        *(LAS u32x4*)(q_ + 2 * QB + vrow * PV + vch * 16) = vreg[set]; } while (0)
    constexpr int NB = DK / 64, NS = DK / 16;
    f32x16 sacc[NB];
#pragma unroll
    for (int j = 0; j < NB; ++j)
#pragma unroll
        for (int r = 0; r < 16; ++r) sacc[j][r] = 0.f;
    for (int e = tid; e < STB / 16; e += 512) *(LAS u32x4*)(lds + ST0 + e * 16) = (u32x4){0u, 0u, 0u, 0u};
    WK_LOAD(0, dir ? 63 : 0); WK_STORE(0, 0); WK_LOAD(0, dir ? 62 : 1); WK_LOAD(1, dir ? 61 : 2);
    const int dsd = (NB == 2 ? ((w - 4) & 3) : (((w - 4) & 3) >> 1)) * 32 + r32;
    float dl_next = *(const GAS float*)(dec + (size_t)(dir ? 63 : 0) * DK + dsd);
    __syncthreads();
    for (int i2 = 0; i2 < 64; i2 += 2)
#pragma unroll
    for (int u_ = 0; u_ < 2; ++u_) {
        const int i = i2 + u_;
        const int n = dir ? 63 - i : i;
        const float dl = dl_next;
        if (i < 63) dl_next = *(const GAS float*)(dec + (size_t)(dir ? n - 1 : n + 1) * DK + dsd);
        const size_t t0 = (size_t)b * SEQ + (size_t)n * 64;
        const LAS unsigned char* Qs = lds + u_ * TB; const LAS unsigned char* Ks = Qs + QB; const LAS unsigned char* Vs = Ks + QB;
        const LAS unsigned char* STc = lds + ST0 + u_ * STB; LAS unsigned char* STn = lds + ST0 + (u_ ^ 1) * STB;
        if (w < 4) {
            const int cb = w & 1, vb = w >> 1;
            f32x16 pt0, pt1, oacc;
#pragma unroll
            for (int r = 0; r < 16; ++r) { pt0[r] = 0.f; pt1[r] = 0.f; oacc[r] = 0.f; }
            const LAS unsigned char* vb0 = Vs + (4 * hi + qq) * PV + (vb * 32 + 16 * blk + 4 * pp) * 2;
            s16x4 vf[8];
#pragma unroll
            for (int jb = 0; jb < 2; ++jb)
#pragma unroll
                for (int s2 = 0; s2 < 2; ++s2) { const LAS unsigned char* ad = vb0 + (jb * 32 + 16 * s2) * PV; vf[(jb * 2 + s2) * 2] = vtr(ad); vf[(jb * 2 + s2) * 2 + 1] = vtr(ad + 8 * PV); }
            const LAS unsigned char* qa = Qs + (cb * 32 + r32) * PQ + hi * 16; const LAS unsigned char* ka = Ks + r32 * PQ + hi * 16; const LAS unsigned char* sa = STc + (vb * 32 + r32) * PQ + hi * 16;
            bf16x8 fq_[2], fk0[2], fk1[2], fs[2];
            fq_[0] = *(const LAS bf16x8*)qa; fk0[0] = *(const LAS bf16x8*)ka; fk1[0] = *(const LAS bf16x8*)(ka + 32 * PQ); fs[0] = *(const LAS bf16x8*)sa;
#pragma unroll
            for (int s = 0; s < NS; ++s) {
                if (s + 1 < NS) { const int o_ = (s + 1) * 32; fq_[(s + 1) & 1] = *(const LAS bf16x8*)(qa + o_); fk0[(s + 1) & 1] = *(const LAS bf16x8*)(ka + o_); fk1[(s + 1) & 1] = *(const LAS bf16x8*)(ka + 32 * PQ + o_); fs[(s + 1) & 1] = *(const LAS bf16x8*)(sa + o_); }
                __builtin_amdgcn_sched_barrier(0);
                pt0 = __builtin_amdgcn_mfma_f32_32x32x16_bf16(fk0[s & 1], fq_[s & 1], pt0, 0, 0, 0);
                pt1 = __builtin_amdgcn_mfma_f32_32x32x16_bf16(fk1[s & 1], fq_[s & 1], pt1, 0, 0, 0);
                oacc = __builtin_amdgcn_mfma_f32_32x32x16_bf16(fs[s & 1], fq_[s & 1], oacc, 0, 0, 0);
                __builtin_amdgcn_sched_barrier(0);
            }
            const int c = cb * 32 + r32;
#pragma unroll
            for (int r = 0; r < 16; ++r) { const int j0 = crow(r, hi), j1 = 32 + j0;
                const bool k0_ = dir ? (j0 >= c) : (j0 <= c), k1_ = dir ? (j1 >= c) : (j1 <= c);
                pt0[r] = k0_ ? pt0[r] : 0.f; pt1[r] = k1_ ? pt1[r] : 0.f; }
            u32x4 pw[2][2];
#pragma unroll
            for (int s2 = 0; s2 < 2; ++s2) {
                pw[0][s2] = (u32x4){cvtpk(pt0[8 * s2 + 0], pt0[8 * s2 + 1]), cvtpk(pt0[8 * s2 + 2], pt0[8 * s2 + 3]), cvtpk(pt0[8 * s2 + 4], pt0[8 * s2 + 5]), cvtpk(pt0[8 * s2 + 6], pt0[8 * s2 + 7])};
                pw[1][s2] = (u32x4){cvtpk(pt1[8 * s2 + 0], pt1[8 * s2 + 1]), cvtpk(pt1[8 * s2 + 2], pt1[8 * s2 + 3]), cvtpk(pt1[8 * s2 + 4], pt1[8 * s2 + 5]), cvtpk(pt1[8 * s2 + 6], pt1[8 * s2 + 7])};
            }
#pragma unroll
            for (int jb = 0; jb < 2; ++jb)
#pragma unroll
                for (int s2 = 0; s2 < 2; ++s2)
                    oacc = __builtin_amdgcn_mfma_f32_32x32x16_bf16(cat8(vf[(jb * 2 + s2) * 2], vf[(jb * 2 + s2) * 2 + 1]), __builtin_bit_cast(bf16x8, pw[jb][s2]), oacc, 0, 0, 0);
            bf16_t* op = Op + (t0 + c) * (size_t)opitch + vb * 32 + 4 * hi;
#pragma unroll
            for (int g = 0; g < 4; ++g) { u32x2 wv; wv.x = cvtpk(oacc[4 * g], oacc[4 * g + 1]); wv.y = cvtpk(oacc[4 * g + 2], oacc[4 * g + 3]); *(GAS u32x2*)(op + 8 * g) = wv; }
        } else {
            const int sdb = w - 4;
            {
                const int sd = NB == 2 ? sdb : (sdb >> 1), sv0 = NB == 2 ? 0 : (sdb & 1);
                const LAS unsigned char* kb0 = Ks + (8 * hi + qq) * PQ + (sd * 32 + 16 * blk + 4 * pp) * 2;
                s16x4 kf[8];
#pragma unroll
                for (int ks = 0; ks < 4; ++ks) { kf[2 * ks] = vtr(kb0 + 16 * ks * PQ); kf[2 * ks + 1] = vtr(kb0 + (16 * ks + 4) * PQ); }
#pragma unroll
                for (int j = 0; j < NB; ++j) {
                    const int sv = sv0 + j;
                    const LAS unsigned char* va0 = Vs + (8 * hi + qq) * PV + (sv * 32 + 16 * blk + 4 * pp) * 2;
                    s16x4 af[8];
#pragma unroll
                    for (int ks = 0; ks < 4; ++ks) { af[2 * ks] = vtr(va0 + 16 * ks * PV); af[2 * ks + 1] = vtr(va0 + (16 * ks + 4) * PV); }
#pragma unroll
                    for (int ks = 0; ks < 4; ++ks) sacc[j] = __builtin_amdgcn_mfma_f32_32x32x16_bf16(cat8(af[2 * ks], af[2 * ks + 1]), cat8(kf[2 * ks], kf[2 * ks + 1]), sacc[j], 0, 0, 0);
#pragma unroll
                    for (int r = 0; r < 16; ++r) { sacc[j][r] *= dl; *(LAS bf16_t*)(STn + (sv * 32 + crow(r, hi)) * PQ + (sd * 32 + r32) * 2) = f2bf(sacc[j][r]); }
                }
            }
        }
        if (i < 63) { WK_STORE(u_, (u_ + 1) & 1); if (i < 61) WK_LOAD(u_, dir ? n - 3 : n + 3); }
        __syncthreads();
    }
#undef WK_LOAD
#undef WK_STORE
}

template <int NPL>
__device__ __forceinline__ void post_phase(bf16_t* of, const bf16_t* ob, const bf16_t* gt, const float* gain, int gw, int NGW, int lane) {
    float gn[NPL];
#pragma unroll
    for (int i = 0; i < NPL; ++i) gn[i] = gain[(lane & 15) * NPL + i];
    constexpr int R = 4;
    for (int m0 = gw; m0 < T; m0 += R * NGW) {
        u32x4 a[R][NPL / 8], bq[R][NPL / 8], gg[R][NPL / 8];
#pragma unroll
        for (int q = 0; q < R; ++q) { const int m = (m0 + q * NGW) < T ? (m0 + q * NGW) : m0;
#pragma unroll
            for (int c = 0; c < NPL / 8; ++c) { a[q][c] = *(const GA1 u32x4*)(of + (size_t)m * D + lane * NPL + 8 * c); bq[q][c] = *(const GA1 u32x4*)(ob + (size_t)m * PP + lane * NPL + 8 * c); gg[q][c] = *(const GA1 u32x4*)(gt + (size_t)m * PP + lane * NPL + 8 * c); } }
#pragma unroll
        for (int q = 0; q < R; ++q) { const int m = m0 + q * NGW; if (m >= T) break;
            float v[NPL], g[NPL]; float ss = 0.f;
#pragma unroll
            for (int c = 0; c < NPL / 8; ++c)
#pragma unroll
                for (int e = 0; e < 4; ++e) { v[8 * c + 2 * e] = bflo(a[q][c][e]) + bflo(bq[q][c][e]); v[8 * c + 2 * e + 1] = bfhi(a[q][c][e]) + bfhi(bq[q][c][e]); g[8 * c + 2 * e] = bflo(gg[q][c][e]); g[8 * c + 2 * e + 1] = bfhi(gg[q][c][e]); }
#pragma unroll
            for (int i = 0; i < NPL; ++i) ss += v[i] * v[i];
            ss += __shfl_xor(ss, 1); ss += __shfl_xor(ss, 2); ss += __shfl_xor(ss, 4); ss += __shfl_xor(ss, 8);
            const float rs = rsqrtf(ss * (1.f / (16.f * NPL)) + EPS);
            bf16_t* pf = of + (size_t)m * D + lane * NPL;
#pragma unroll
            for (int c = 0; c < NPL / 8; ++c) { u32x4 o;
#pragma unroll
                for (int e = 0; e < 4; ++e) { const int i0 = 8 * c + 2 * e; o[e] = cvtpk(v[i0] * rs * gn[i0] * silu_f(g[i0]), v[i0 + 1] * rs * gn[i0 + 1] * silu_f(g[i0 + 1])); }
                *(GA1 u32x4*)(pf + 8 * c) = o; }
        }
    }
}

#ifdef NO_SW
#define GEMM_SW if (0)
#else
#define GEMM_SW
#endif
#ifdef NO_RES
#define GEMM_RES if (0)
#else
#define GEMM_RES
#endif
#ifdef NO_PROJ
#define GEMM_PROJ if (0)
#else
#define GEMM_PROJ
#endif
constexpr int LDS_BYTES = 147456;
struct Args { const void* in[30]; float* out; unsigned char* ws; };
#define INF(i) ((const float*)args.in[i])

constexpr int NPHASE = 20;
#ifndef DBG_STOP
#define DBG_STOP NPHASE
#endif
__global__ void __launch_bounds__(512, 2) mega_fwd(Args args) {
    extern __shared__ __attribute__((aligned(16))) unsigned char lds_raw[];
    LAS unsigned char* lds = (LAS unsigned char*)lds_raw;
    cg::grid_group grid = cg::this_grid();
    volatile LAS unsigned* MISC = (volatile LAS unsigned*)(lds + 131072 + 320);
    if (threadIdx.x < 64) MISC[threadIdx.x] = 0u;
    __syncthreads();
    grid.sync();
    XcdBarrier bar = xcd_barrier_post((unsigned*)args.ws + 4096, MISC + 8);
    if (threadIdx.x == 0) { const unsigned x_ = xb_xcc_id(); const unsigned r_ = __hip_atomic_fetch_add((unsigned*)args.ws + 64 + x_, 1u, __ATOMIC_RELAXED, __HIP_MEMORY_SCOPE_AGENT); MISC[20] = r_; MISC[21] = x_; MISC[22] = blockIdx.x; }
    __syncthreads();
#pragma unroll 1
    for (int ph = 0; ph < NPHASE; ++ph) {
        if (ph == 1) {
            if (threadIdx.x == 0) { bool ok_ = gridDim.x == 256;
                for (int j = 0; j < 8; ++j) ok_ = ok_ && (__hip_atomic_load((unsigned*)args.ws + 64 + j, __ATOMIC_RELAXED, __HIP_MEMORY_SCOPE_AGENT) == 32u);
                if (ok_) MISC[22] = MISC[20] * 8u + MISC[21]; }
            __syncthreads();
        }
        int tid_ = threadIdx.x; asm volatile("" : "+v"(tid_)); int bid_ = (int)__builtin_amdgcn_readfirstlane((int)MISC[22]); asm volatile("" : "+s"(bid_));
        const int tid = tid_, lane = tid & 63, wave = __builtin_amdgcn_readfirstlane(tid >> 6);
        const int G = gridDim.x, gw = bid_ * 8 + wave, NGW = G * 8;
        unsigned char* ws = args.ws; asm volatile("" : "+s"(ws));
        float* xfin = (float*)(ws + WS_C);
        bf16_t* A = (bf16_t*)(ws + WS_A); bf16_t* B = (bf16_t*)(ws + WS_B);
        bf16_t* XB = (bf16_t*)args.out;
        bf16_t* QGf = (bf16_t*)(ws + WS_C); bf16_t* KGf = (bf16_t*)(ws + WS_C + 32 * MiB); bf16_t* QGb = (bf16_t*)(ws + WS_C + 64 * MiB); bf16_t* KGb = (bf16_t*)(ws + WS_C + 96 * MiB);
        float* LR = (float*)(ws + WS_LR); float* DECf = (float*)(ws + WS_DEC); float* DECb = (float*)(ws + WS_DEC + 1 * MiB);
        float* SSB = (float*)(ws + WS_SS);
        const int layer = ph > 9 ? 1 : 0, step = (ph == 0 || ph == NPHASE - 1) ? -1 : (ph - 1) - 9 * layer;
        if (ph >= DBG_STOP && ph != NPHASE - 1) {
        } else if (ph == 0) {
            {
            LAS float* scr = (LAS float*)(lds + wave * 16384);
            int it = gw;
#pragma unroll 1
            for (int f = 0; f < 4; ++f) {
                const int ly = f >> 1, which = f & 1;
                const float* wg = INF(which ? 7 : 3) + (size_t)ly * D * FF; const float* wu = INF(which ? 8 : 4) + (size_t)ly * D * FF; const float* wd = INF(which ? 9 : 5) + (size_t)ly * FF * D;
                const float* gn = INF(which ? 6 : 2) + ly * D;
                bf16_t* gu = (bf16_t*)(ws + WS_WGU) + (size_t)f * 5632 * 1024; bf16_t* dn = (bf16_t*)(ws + WS_WD) + (size_t)f * 1024 * 2816;
                constexpr int IG = 16 * 88, ID = 44 * 32;
                for (; it < IG; it += NGW) tr_item(wg, D, FF, gu, 1, 1.f, 0, 0, gn, scr, it, lane);
                it -= IG;
                for (; it < IG; it += NGW) tr_item(wu, D, FF, gu, 2, 1.f, 0, 0, gn, scr, it, lane);
                it -= IG;
                for (; it < ID; it += NGW) tr_item(wd, FF, D, dn, 0, 1.f, 0, 0, nullptr, scr, it, lane);
                it -= ID;
            }
            {
                constexpr int I0 = 16 * 96, I1 = 16 * 32, I2 = 16 * 97;
                for (; it < I0; it += NGW) tr_item(INF(11), D, 3072, (bf16_t*)(ws + WS_WIN0), 0, 0.125f * 1.4426950408889634f, 0, 512, INF(10), scr, it, lane);
                it -= I0;
                for (; it < I1; it += NGW) tr_item(INF(20), D, D, (bf16_t*)(ws + WS_WOUT0), 0, 1.f, 0, 0, nullptr, scr, it, lane);
                it -= I1;
                for (; it < I2; it += NGW) tr_item(INF(22), D, 3104, (bf16_t*)(ws + WS_WIN1), 0, 0.08838834764831845f, 0, 512, INF(21), scr, it, lane);
                it -= I2;
                for (; it < I1; it += NGW) tr_item(INF(28), D, D, (bf16_t*)(ws + WS_WOUT1), 0, 1.f, 0, 0, nullptr, scr, it, lane);
            }
            { GA1 u32x4* z = (GA1 u32x4*)((bf16_t*)(ws + WS_WIN1) + (size_t)3104 * 1024); for (int e = bid_ * 512 + tid; e < 224 * 1024 / 8; e += G * 512) z[e] = (u32x4){0u, 0u, 0u, 0u}; }
            }
#ifdef DBL_PRO2
            {
            LAS float* scr = (LAS float*)(lds + wave * 16384);
            int it = gw;
#pragma unroll 1
            for (int f = 0; f < 4; ++f) {
                const int ly = f >> 1, which = f & 1;
                const float* wg = INF(which ? 7 : 3) + (size_t)ly * D * FF; const float* wu = INF(which ? 8 : 4) + (size_t)ly * D * FF; const float* wd = INF(which ? 9 : 5) + (size_t)ly * FF * D;
                const float* gn = INF(which ? 6 : 2) + ly * D;
                bf16_t* gu = (bf16_t*)(ws + WS_WGU) + (size_t)f * 5632 * 1024; bf16_t* dn = (bf16_t*)(ws + WS_WD) + (size_t)f * 1024 * 2816;
                constexpr int IG = 16 * 88, ID = 44 * 32;
                for (; it < IG; it += NGW) tr_item(wg, D, FF, gu, 1, 1.f, 0, 0, gn, scr, it, lane);
                it -= IG;
                for (; it < IG; it += NGW) tr_item(wu, D, FF, gu, 2, 1.f, 0, 0, gn, scr, it, lane);
                it -= IG;
                for (; it < ID; it += NGW) tr_item(wd, FF, D, dn, 0, 1.f, 0, 0, nullptr, scr, it, lane);
                it -= ID;
            }
            {
                constexpr int I0 = 16 * 96, I1 = 16 * 32, I2 = 16 * 97;
                for (; it < I0; it += NGW) tr_item(INF(11), D, 3072, (bf16_t*)(ws + WS_WIN0), 0, 0.125f * 1.4426950408889634f, 0, 512, INF(10), scr, it, lane);
                it -= I0;
                for (; it < I1; it += NGW) tr_item(INF(20), D, D, (bf16_t*)(ws + WS_WOUT0), 0, 1.f, 0, 0, nullptr, scr, it, lane);
                it -= I1;
                for (; it < I2; it += NGW) tr_item(INF(22), D, 3104, (bf16_t*)(ws + WS_WIN1), 0, 0.08838834764831845f, 0, 512, INF(21), scr, it, lane);
                it -= I2;
                for (; it < I1; it += NGW) tr_item(INF(28), D, D, (bf16_t*)(ws + WS_WOUT1), 0, 1.f, 0, 0, nullptr, scr, it, lane);
            }
            { GA1 u32x4* z = (GA1 u32x4*)((bf16_t*)(ws + WS_WIN1) + (size_t)3104 * 1024); for (int e = bid_ * 512 + tid; e < 224 * 1024 / 8; e += G * 512) z[e] = (u32x4){0u, 0u, 0u, 0u}; }
            }
#endif
            cast_phase(INF(0), XB, SSB, gw, NGW, lane);
        } else if (ph == NPHASE - 1) {
            final_phase(A, SSB + (size_t)6 * T * 16, INF(29), args.out, gw, NGW, lane);
        } else if (step == 0 || step == 7) {
            const int f = layer * 2 + (step == 7 ? 1 : 0);
            pg8::Gemm g{XB, (const bf16_t*)(ws + WS_WGU) + (size_t)f * 5632 * 1024, T, 5632, D}; pg8::StaticOrder S; S.init(T, 5632, G, bid_);
            EpiSwiglu E{B, SSB + (size_t)(3 * layer + (step == 7 ? 2 : 0)) * T * 16};
            GEMM_SW pg8::gemm_phase<EpiSwiglu, pg8::StaticOrder, true, true>(lds, g, S, E);
#ifdef DBL_GU
            GEMM_SW pg8::gemm_phase<EpiSwiglu, pg8::StaticOrder, true, true>(lds, g, S, E);
#endif
        } else if (step == 1 || step == 8 || step == 6) {
            const int f = layer * 2 + (step == 8 ? 1 : 0);
            const bf16_t* Am = step == 6 ? A : B;
            const bf16_t* Wm = step == 6 ? (const bf16_t*)(ws + (layer == 0 ? WS_WOUT0 : WS_WOUT1)) : (const bf16_t*)(ws + WS_WD) + (size_t)f * 1024 * 2816;
            pg8::Gemm g{Am, Wm, T, D, step == 6 ? D : FF}; pg8::StaticOrder S; S.init(T, D, G, bid_);
            const bool last = (layer == 1 && step == 8);
            const bf16_t* e_xb = XB; bf16_t* e_out = last ? A : XB; float e_alpha = step == 6 ? 1.0f : 0.5f; float* e_ss = SSB + (size_t)(3 * layer + (step == 1 ? 1 : step == 6 ? 2 : 3)) * T * 16;
            asm volatile("" : "+s"(e_xb), "+s"(e_out), "+s"(e_alpha), "+s"(e_ss));
            EpiRes E{e_xb, e_out, e_alpha, e_ss};
            GEMM_RES pg8::gemm_phase<EpiRes, pg8::StaticOrder, true, true>(lds, g, S, E);
        } else if (step == 2) {
            const int N = layer == 0 ? 3072 : 3328;
            pg8::Gemm g{XB, (const bf16_t*)(ws + (layer == 0 ? WS_WIN0 : WS_WIN1)), T, N, D}; pg8::StaticOrder S; S.init(T, N, G, bid_);
            EpiProj E{B, LR, SSB + (size_t)(3 * layer + 1) * T * 16};
            GEMM_PROJ pg8::gemm_phase<EpiProj, pg8::StaticOrder, true, true>(lds, g, S, E);
#ifdef DBL_PROJ
            GEMM_PROJ pg8::gemm_phase<EpiProj, pg8::StaticOrder, true, true>(lds, g, S, E);
#endif
        } else if (step == 3) {
            if (layer == 0) prep0_phase(B, (const int*)args.in[1], INF(17), INF(18), QGf, KGf, QGb, KGb, DECf, DECb, gw, NGW, lane);
            else { prep1_phase(B, LR, INF(23), INF(24), INF(25), INF(26), QGf, KGf, QGb, KGb, DECf, DECb, tid, lds, bid_, G);
#ifdef DBL_PREP1
                prep1_phase(B, LR, INF(23), INF(24), INF(25), INF(26), QGf, KGf, QGb, KGb, DECf, DECb, tid, lds, bid_, G);
#endif
 }
        } else if (step == 4) {
            if (layer == 0) {
                float s1 = 0.f, s2 = 0.f;
                for (int i = 0; i < 64; ++i) { s1 += INF(12)[i] * INF(13)[i]; s2 += INF(14)[i] * INF(15)[i]; }
                const float lam_init = 0.2f, lam = expf(s1) - expf(s2) + lam_init;
#ifndef SKIP_ATTN
#pragma unroll 1
                for (int u = bid_; u < 1024; u += G) { const int i = u >> 8, bx = u & 255, bh = (bx & 7) * 4 + i, qb = bx >> 3;
                    attn_unit(lds, B, A, bh >> 2, bh & 3, qb, lam, INF(16), 1.f - lam_init);
#ifdef DBL_ATTN
                    attn_unit(lds, B, A, bh >> 2, bh & 3, qb, lam, INF(16), 1.f - lam_init);
#endif
 }
#endif
#ifndef SKIP_WALK
#pragma unroll 1
                for (int u = bid_; u < 128; u += G) { const int x = u & 7, y = u >> 3, vs = y & 1, dir = (y >> 1) & 1, bh = x * 4 + (y >> 2), b = bh >> 2, h = bh & 3;
#define WALK0_CALL                     walk_unit<64>(lds, dir ? QGb : QGf, dir ? KGb : KGf, h, B + 2048 + h * 128 + vs * 64, (dir ? DECb : DECf) + (size_t)bh * 64 * 64, \
                                  dir ? (B + 1536 + h * 128 + vs * 64) : (A + 512 + h * 128 + vs * 64), dir ? PP : D, b, dir);
                    WALK0_CALL
#ifdef DBL_WALK
                    WALK0_CALL
#endif
 }
#endif
            } else {
#ifndef SKIP_WALK
#pragma unroll 1
                for (int u = bid_; u < 256; u += G) { const int x = u & 7, y = u >> 3, vs = y & 3, dir = (y >> 2) & 1, bh = x * 4 + (y >> 3), b = bh >> 2, h = bh & 3;
#define WALK1_CALL                     walk_unit<128>(lds, dir ? QGb : QGf, dir ? KGb : KGf, h, B + 1024 + h * 256 + vs * 64, (dir ? DECb : DECf) + (size_t)bh * 64 * 128, \
                                   dir ? (B + h * 256 + vs * 64) : (A + h * 256 + vs * 64), dir ? PP : D, b, dir);
                    WALK1_CALL
#ifdef DBL_WALK
                    WALK1_CALL
#endif
 }
#endif
            }
        } else if (step == 5) {
            if (layer == 0) post_phase<8>(A + 512, B + 1536, B + 2560, INF(19), gw, NGW, lane);
            else post_phase<16>(A, B, B + 2048, INF(27), gw, NGW, lane);
        }
        if (ph + 1 < NPHASE) xcd_barrier(bar);
#ifdef DBL_BAR
        if (ph + 1 < NPHASE) xcd_barrier(bar);
#endif
    }
}

extern "C" void kernel_launch(void* const* d_in, const int* in_sizes, int n_in, void* d_out, int out_size, void* d_ws, size_t ws_size, hipStream_t stream) {
    static int grid = 0;
    if (grid == 0) {
        if (n_in != 30 || out_size != T * D || ws_size < WS_END) { fprintf(stderr, "kernel_launch: unexpected shapes (n_in %d out %d ws %zu)\n", n_in, out_size, ws_size); grid = -1; return; }
        int dev = 0, cus = 0, per_cu = 0;
        (void)hipGetDevice(&dev); (void)hipDeviceGetAttribute(&cus, hipDeviceAttributeMultiprocessorCount, dev);
        if (hipFuncSetAttribute((const void*)mega_fwd, hipFuncAttributeMaxDynamicSharedMemorySize, LDS_BYTES) != hipSuccess) { fprintf(stderr, "kernel_launch: hipFuncSetAttribute failed\n"); }
        if (hipOccupancyMaxActiveBlocksPerMultiprocessor(&per_cu, (const void*)mega_fwd, 512, LDS_BYTES) != hipSuccess || per_cu < 1) per_cu = 1;
        (void)hipGetLastError();
        grid = cus * per_cu;
        if (grid <= 0) grid = 256;
    }
    if (grid < 0) return;
    Args a{};
    for (int i = 0; i < 30; ++i) a.in[i] = d_in[i];
    a.out = (float*)d_out; a.ws = (unsigned char*)d_ws;
    (void)hipMemsetAsync(d_ws, 0, 65536, stream);
    void* kargs[] = {&a};
    hipError_t e = hipLaunchCooperativeKernel((const void*)mega_fwd, dim3(grid), dim3(512), kargs, LDS_BYTES, stream);
    if (e != hipSuccess) fprintf(stderr, "cooperative launch failed: %s (grid %d)\n", hipGetErrorString(e), grid);
}
```

```cpp
#include <hip/hip_runtime.h>
#include <hip/hip_cooperative_groups.h>
#include <cstdio>
#include <cstdint>
namespace cg = cooperative_groups;
namespace pg8 {
#define PG8_LAS __attribute__((address_space(3)))
typedef unsigned short bf16_t;
typedef short bf16x8 __attribute__((ext_vector_type(8)));
typedef float f32x4 __attribute__((ext_vector_type(4)));
typedef unsigned u32x4 __attribute__((ext_vector_type(4)));
constexpr int BM = 256, BK = 64, HALF = 128, HTB = HALF * BK * 2  , STAGE_BYTES = 8 * HTB, NXCD = 8, WGM = 8;

__host__ __device__ __forceinline__ int lds_byte(int r, int c) { const int st = (r >> 4) * 2 + (c >> 5), rr = r & 15, cc = c & 31, ob = rr * 64 + cc * 2; return st * 1024 + (ob ^ (((ob >> 9) & 1) << 5)); }
__host__ __device__ __forceinline__ void stage_rc(int b, int& R, int& C) { const int st = b / 1024, sb = b % 1024, swz = sb ^ (((sb >> 9) & 1) << 5); R = (st >> 1) * 16 + swz / 64; C = (st & 1) * 32 + (swz % 64) / 2; }
__host__ __device__ __forceinline__ int perm32(int rho) { const int n = rho >> 4, i = rho & 15; return 8 * (i >> 2) + 4 * n + (i & 3); }

struct Unit { int pm, pn; };
struct Gemm { const bf16_t* A; const bf16_t* Bt; int M, N, K; };

struct StaticOrder {
    int nM, nN, nwg, G, c;
    __host__ __device__ void init(int M, int N, int G_, int c_) { nM = M / BM; nN = N / BM; nwg = nM * nN; G = G_; c = c_; }
    __host__ __device__ bool next(int i, Unit& u) const {
        const long L = (long)i * G + c; if (L >= nwg) return false;
        int wgid = (int)L; { const int q = nwg / NXCD, r = nwg % NXCD, xcd = wgid % NXCD, off = wgid / NXCD; wgid = (xcd < r ? xcd * (q + 1) : r * (q + 1) + (xcd - r) * q) + off; }
        const int nig = WGM * nN, gid = wgid / nig, fm = gid * WGM, gsz = (nM - fm) < WGM ? (nM - fm) : WGM;
        u.pm = fm + ((wgid % nig) % gsz); u.pn = (wgid % nig) / gsz; return true;
    }
    __device__ __forceinline__ void a_ready(const Unit&) const {}
    __device__ __forceinline__ void done(const Unit&) const {}
};
__device__ __forceinline__ unsigned cvt_pk_bf16(float lo, float hi) { unsigned r; asm volatile("v_cvt_pk_bf16_f32 %0, %1, %2" : "=v"(r) : "v"(lo), "v"(hi)); return r; }
typedef float f32x2 __attribute__((ext_vector_type(2)));
template <class Epi, class Sched, bool ALIGN_EPI = false, bool SP2 = false>
__device__ __forceinline__ void gemm_phase(PG8_LAS unsigned char* lds, const Gemm g, const Sched& S, const Epi& E) {
    int tid_ = threadIdx.x; asm volatile("" : "+v"(tid_)); const int tid = tid_, wid = __builtin_amdgcn_readfirstlane(tid >> 6), lane = tid & 63, wr = wid >> 2, wc = wid & 3, fr = lane & 15, fq = lane >> 4;
    const int K = g.K, nt = K / BK;
    unsigned voffA[2], voffB[2];
#pragma unroll
    for (int i = 0; i < 2; ++i) { int R, C; stage_rc(tid * 16 + i * 8192, R, C); const int Rb = Epi::PERM ? ((R & ~31) + perm32(R & 31)) : R;
        voffA[i] = (unsigned)(R * K + C) * 2u; voffB[i] = (unsigned)(Rb * K + C) * 2u; }
    const size_t kstep = (size_t)(BK * 2);
    const size_t hstep = (size_t)HALF * K * 2;
    const size_t tstep = 2 * hstep;
    const unsigned ldsw = (unsigned)wid * 1024u;
    const int aoff = lds_byte(wr * 64 + fr, fq * 8), boff = lds_byte(wc * 32 + fr, fq * 8);
#define PG8_SA(b, h) (((b) * 2 + (h)) * HTB)
#define PG8_SB(b, h) ((4 + (b) * 2 + (h)) * HTB)
#define PG8_STAGE(bufoff, gbase, voff) do { _Pragma("unroll") for (int _i = 0; _i < 2; ++_i) \
        __builtin_amdgcn_global_load_lds((const unsigned*)((const char*)(gbase) + (voff)[_i]), (PG8_LAS unsigned*)(lds + (bufoff) + ldsw + _i * 8192), 16, 0, 0); } while (0)
#define PG8_LDA(dst, b, h) do { _Pragma("unroll") for (int m = 0; m < 4; ++m) _Pragma("unroll") for (int k = 0; k < 2; ++k) dst[m][k] = *(const PG8_LAS bf16x8*)(lds + PG8_SA(b, h) + aoff + m * 2048 + k * 1024); } while (0)
#define PG8_LDB(dst, b, h) do { _Pragma("unroll") for (int n = 0; n < 2; ++n) _Pragma("unroll") for (int k = 0; k < 2; ++k) dst[n][k] = *(const PG8_LAS bf16x8*)(lds + PG8_SB(b, h) + boff + n * 2048 + k * 1024); } while (0)
#define PG8_MMA(ai, bj, At, Bt) do { __builtin_amdgcn_s_setprio(1); _Pragma("unroll") for (int m = 0; m < 4; ++m) _Pragma("unroll") for (int n = 0; n < 2; ++n) _Pragma("unroll") for (int k = 0; k < 2; ++k) \
        acc[ai][bj][m][n] = __builtin_amdgcn_mfma_f32_16x16x32_bf16(Bt[n][k], At[m][k], acc[ai][bj][m][n], 0, 0, 0); __builtin_amdgcn_s_setprio(0); } while (0)
#define PG8_WAIT_V(n) asm volatile("s_waitcnt vmcnt(" #n ")" ::: "memory")
#define PG8_WAIT_L(n) asm volatile("s_waitcnt lgkmcnt(" #n ")" ::: "memory")
#define PG8_BAR __builtin_amdgcn_s_barrier()
#define PG8_SCHED __builtin_amdgcn_sched_barrier(0)
    Unit cur, nxt; int ui = 0;
    if (!S.next(0, cur)) return;
    f32x4 acc[2][2][4][2];
#pragma unroll
    for (int a = 0; a < 2; ++a)
#pragma unroll
        for (int b = 0; b < 2; ++b)
#pragma unroll
            for (int m = 0; m < 4; ++m)
#pragma unroll
                for (int n = 0; n < 2; ++n) acc[a][b][m][n] = (f32x4){0.f, 0.f, 0.f, 0.f};
    bf16x8 At[4][2], B0[2][2], B1[2][2];
    const char* cA = (const char*)g.A + (size_t)cur.pm * tstep; const char* cB = (const char*)g.Bt + (size_t)cur.pn * tstep;
    S.a_ready(cur);
    if constexpr (SP2) {
        PG8_STAGE(PG8_SB(0, 0), cB, voffB); PG8_STAGE(PG8_SB(0, 1), cB + hstep, voffB); PG8_STAGE(PG8_SA(0, 0), cA, voffA); PG8_STAGE(PG8_SA(0, 1), cA + hstep, voffA);
        if (wr == 1) PG8_BAR;
        PG8_WAIT_V(2); PG8_BAR;
        PG8_STAGE(PG8_SB(1, 0), cB + kstep, voffB); PG8_STAGE(PG8_SA(1, 0), cA + kstep, voffA); PG8_STAGE(PG8_SB(1, 1), cB + hstep + kstep, voffB);
        PG8_WAIT_V(6); PG8_BAR;
    } else {
        PG8_STAGE(PG8_SB(0, 0), cB, voffB); PG8_STAGE(PG8_SA(0, 0), cA, voffA); PG8_STAGE(PG8_SB(0, 1), cB + hstep, voffB); PG8_STAGE(PG8_SA(0, 1), cA + hstep, voffA);
        if (wr == 1) PG8_BAR;
        PG8_WAIT_V(4); PG8_BAR;
        PG8_STAGE(PG8_SB(1, 0), cB + kstep, voffB); PG8_STAGE(PG8_SA(1, 0), cA + kstep, voffA); PG8_STAGE(PG8_SB(1, 1), cB + hstep + kstep, voffB);
        PG8_WAIT_V(6); PG8_BAR;
    }
    for (;;) {
        const bool has_next = S.next(ui + 1, nxt);
        const char* nA = has_next ? (const char*)g.A + (size_t)nxt.pm * tstep : cA; const char* nB = has_next ? (const char*)g.Bt + (size_t)nxt.pn * tstep : cB;
        for (int t = 0; t < nt; t += 2) {
            const bool last = (t == nt - 2);
            const char* a1 = cA + (size_t)(t + 1) * kstep;
            const char* a2 = last ? nA : cA + (size_t)(t + 2) * kstep; const char* b2 = last ? nB : cB + (size_t)(t + 2) * kstep;
            const char* a3 = a2 + kstep; const char* b3 = b2 + kstep;
            if (last && has_next) S.a_ready(nxt);
            if constexpr (SP2) {
            PG8_LDB(B0, 0, 0); PG8_LDB(B1, 0, 1); PG8_SCHED; PG8_LDA(At, 0, 0); PG8_STAGE(PG8_SA(1, 1), a1 + hstep, voffA);
            PG8_WAIT_V(8); PG8_WAIT_L(0); PG8_BAR; PG8_MMA(0, 0, At, B0); PG8_MMA(0, 1, At, B1); PG8_BAR; PG8_SCHED;
            PG8_LDA(At, 0, 1); PG8_STAGE(PG8_SB(0, 0), b2, voffB); PG8_STAGE(PG8_SB(0, 1), b2 + hstep, voffB); PG8_STAGE(PG8_SA(0, 0), a2, voffA);
            PG8_WAIT_V(8); PG8_WAIT_L(0); PG8_BAR; PG8_MMA(1, 0, At, B0); PG8_MMA(1, 1, At, B1); PG8_BAR; PG8_SCHED;
            PG8_LDB(B0, 1, 0); PG8_LDB(B1, 1, 1); PG8_SCHED; PG8_LDA(At, 1, 0); PG8_STAGE(PG8_SA(0, 1), a2 + hstep, voffA);
            PG8_WAIT_V(8); PG8_WAIT_L(0); PG8_BAR; PG8_MMA(0, 0, At, B0); PG8_MMA(0, 1, At, B1); PG8_BAR; PG8_SCHED;
            PG8_LDA(At, 1, 1); PG8_STAGE(PG8_SB(1, 0), b3, voffB); PG8_STAGE(PG8_SB(1, 1), b3 + hstep, voffB); PG8_STAGE(PG8_SA(1, 0), a3, voffA);
            PG8_WAIT_V(8); PG8_WAIT_L(0); PG8_BAR; PG8_MMA(1, 0, At, B0); PG8_MMA(1, 1, At, B1); PG8_BAR; PG8_SCHED;
            } else {
            PG8_LDB(B0, 0, 0); PG8_SCHED; PG8_LDA(At, 0, 0); PG8_STAGE(PG8_SA(1, 1), a1 + hstep, voffA);
            PG8_WAIT_L(8); PG8_BAR; PG8_WAIT_L(0); PG8_MMA(0, 0, At, B0); PG8_BAR; PG8_SCHED;
            PG8_LDB(B1, 0, 1); PG8_STAGE(PG8_SB(0, 0), b2, voffB);
            PG8_BAR; PG8_WAIT_L(0); PG8_MMA(0, 1, At, B1); PG8_BAR;
            PG8_LDA(At, 0, 1); PG8_STAGE(PG8_SA(0, 0), a2, voffA);
            PG8_BAR; PG8_WAIT_L(0); PG8_MMA(1, 0, At, B0); PG8_BAR; PG8_SCHED;
            PG8_STAGE(PG8_SB(0, 1), b2 + hstep, voffB);
            PG8_WAIT_V(6); PG8_BAR; PG8_MMA(1, 1, At, B1); PG8_BAR;
            PG8_LDB(B0, 1, 0); PG8_SCHED; PG8_LDA(At, 1, 0); PG8_STAGE(PG8_SA(0, 1), a2 + hstep, voffA);
            PG8_WAIT_L(8); PG8_BAR; PG8_WAIT_L(0); PG8_MMA(0, 0, At, B0); PG8_BAR; PG8_SCHED;
            PG8_LDB(B1, 1, 1); PG8_STAGE(PG8_SB(1, 0), b3, voffB);
            PG8_BAR; PG8_WAIT_L(0); PG8_MMA(0, 1, At, B1); PG8_BAR;
            PG8_LDA(At, 1, 1); PG8_STAGE(PG8_SA(1, 0), a3, voffA);
            PG8_BAR; PG8_WAIT_L(0); PG8_MMA(1, 0, At, B0); PG8_BAR; PG8_SCHED;
            PG8_STAGE(PG8_SB(1, 1), b3 + hstep, voffB);
            PG8_WAIT_V(6); PG8_BAR; PG8_MMA(1, 1, At, B1); PG8_BAR;
            }
        }
        if constexpr (ALIGN_EPI) { if (wr == 0) PG8_BAR; }
        if constexpr (!Epi::AFTER_DRAIN) { E(acc, cur, wr, wc, fr, fq); S.done(cur); }
        if (!has_next) break;
#pragma unroll
        for (int a = 0; a < 2; ++a)
#pragma unroll
            for (int b = 0; b < 2; ++b)
#pragma unroll
                for (int m = 0; m < 4; ++m)
#pragma unroll
                    for (int n = 0; n < 2; ++n) acc[a][b][m][n] = (f32x4){0.f, 0.f, 0.f, 0.f};
        cur = nxt; cA = nA; cB = nB; ++ui;
        if constexpr (ALIGN_EPI) { if (wr == 1) PG8_BAR; }
    }
    PG8_WAIT_V(0);
    if constexpr (!ALIGN_EPI) { if (wr == 0) PG8_BAR; }
    PG8_BAR;
    if constexpr (Epi::AFTER_DRAIN) { E.fused(acc, cur, wr, wc, fr, fq, lds, wid, lane); S.done(cur); }
#undef PG8_SA
#undef PG8_SB
#undef PG8_STAGE
#undef PG8_LDA
#undef PG8_LDB
#undef PG8_MMA
#undef PG8_WAIT_V
#undef PG8_WAIT_L
#undef PG8_BAR
#undef PG8_SCHED
}
}
#define LAS __attribute__((address_space(3)))
#define GA1 __attribute__((address_space(1)))
typedef unsigned short bf16_t;
typedef short bf16x8 __attribute__((ext_vector_type(8)));
typedef short s16x4 __attribute__((ext_vector_type(4)));
typedef short v4i16_t __attribute__((ext_vector_type(4)));
typedef float f32x4 __attribute__((ext_vector_type(4)));
typedef float f32x16 __attribute__((ext_vector_type(16)));
typedef unsigned u32x4 __attribute__((ext_vector_type(4)));
typedef unsigned u32x2 __attribute__((ext_vector_type(2)));

constexpr int T = 32768, D = 1024, FF = 2816, SEQ = 4096, PP = 3072;
constexpr float EPS = 1e-6f;
constexpr size_t MiB = 1u << 20;
constexpr size_t WS_WGU = 1 * MiB;
constexpr size_t WS_WD = WS_WGU + 44 * MiB;
constexpr size_t WS_WIN0 = WS_WD + 22 * MiB;
constexpr size_t WS_WOUT0 = WS_WIN0 + 6 * MiB;
constexpr size_t WS_WIN1 = WS_WOUT0 + 2 * MiB;
constexpr size_t WS_WOUT1 = WS_WIN1 + 7 * MiB;
constexpr size_t WS_A = 84 * MiB;
constexpr size_t WS_B = 148 * MiB;
constexpr size_t WS_C = 340 * MiB;
constexpr size_t WS_LR = 468 * MiB;
constexpr size_t WS_DEC = 472 * MiB;
constexpr size_t WS_SS = 476 * MiB;
constexpr size_t WS_END = 490 * MiB;
static_assert(WS_WOUT1 + 2 * MiB <= WS_A, "ws map");

typedef float f32x2_t __attribute__((ext_vector_type(2))); typedef __bf16 bf16x2_t __attribute__((ext_vector_type(2)));
__device__ __forceinline__ unsigned cvtpk(float lo, float hi) { f32x2_t v = {lo, hi}; bf16x2_t b = __builtin_convertvector(v, bf16x2_t); return __builtin_bit_cast(unsigned, b); }
__device__ __forceinline__ float bf2f(bf16_t b) { return __uint_as_float((unsigned)b << 16); }
__device__ __forceinline__ float bflo(unsigned w) { return __uint_as_float(w << 16); }
__device__ __forceinline__ float bfhi(unsigned w) { return __uint_as_float(w & 0xffff0000u); }
__device__ __forceinline__ bf16_t f2bf(float f) { return (bf16_t)(cvtpk(f, 0.f) & 0xffffu); }
__device__ __forceinline__ int crow(int r, int hi) { return (r & 3) + 8 * (r >> 2) + 4 * hi; }
__device__ __forceinline__ s16x4 vtr(const LAS unsigned char* p) { return __builtin_bit_cast(s16x4, __builtin_amdgcn_ds_read_tr16_b64_v4i16((LAS v4i16_t*)p)); }
__device__ __forceinline__ bf16x8 cat8(s16x4 a, s16x4 b) { return (bf16x8){a[0], a[1], a[2], a[3], b[0], b[1], b[2], b[3]}; }
__device__ __forceinline__ float wave_sum(float v) {
#pragma unroll
    for (int o = 1; o < 64; o <<= 1) v += __shfl_xor(v, o);
    return v;
}
__device__ __forceinline__ float silu_f(float g) { return g * __builtin_amdgcn_rcpf(1.f + __expf(-g)); }
__device__ __forceinline__ void sincos_rev(float ang, float& sn, float& cs) {
    const double rev = (double)ang * 0.15915494309189535; const float fr = (float)(rev - floor(rev));
    sn = __builtin_amdgcn_sinf(fr); cs = __builtin_amdgcn_cosf(fr);
}
__device__ __forceinline__ float logsig(float z) { return fminf(z, 0.f) - log1pf(expf(-fabsf(z))); }

__device__ __forceinline__ void rows_rs(const float* SS, int row0, int fq, float (&rsv)[2][4]) {
    f32x4 p[2][4];
#pragma unroll
    for (int ai = 0; ai < 2; ++ai)
#pragma unroll
        for (int m = 0; m < 4; ++m) p[ai][m] = *(const GA1 f32x4*)(SS + (size_t)(row0 + ai * 128 + m * 16) * 16 + fq * 4);
#pragma unroll
    for (int ai = 0; ai < 2; ++ai)
#pragma unroll
        for (int m = 0; m < 4; ++m) { float s = (p[ai][m][0] + p[ai][m][1]) + (p[ai][m][2] + p[ai][m][3]); s += __shfl_xor(s, 16); s += __shfl_xor(s, 32); rsv[ai][m] = rsqrtf(s * (1.f / D) + EPS); }
}
struct EpiSwiglu {
    static constexpr bool PERM = true, AFTER_DRAIN = false;
    bf16_t* O; const float* SS;
    __device__ __forceinline__ void operator()(const f32x4 (&acc)[2][2][4][2], const pg8::Unit& u, int wr, int wc, int fr, int fq) const {
        const int row0 = u.pm * 256 + wr * 64 + fr, f0 = u.pn * 128 + wc * 32 + 8 * fq;
        float rsv[2][4]; rows_rs(SS, row0, fq, rsv);
#pragma unroll
        for (int ai = 0; ai < 2; ++ai)
#pragma unroll
            for (int m = 0; m < 4; ++m) {
                const int row = row0 + ai * 128 + m * 16;
                const float rs = rsv[ai][m];
                bf16_t* p = O + (size_t)row * FF + f0;
                const f32x4 g0 = acc[ai][0][m][0] * rs, g1 = acc[ai][0][m][1] * rs, u0 = acc[ai][1][m][0] * rs, u1 = acc[ai][1][m][1] * rs;
                u32x4 w;
                w.x = cvtpk(silu_f(g0[0]) * u0[0], silu_f(g0[1]) * u0[1]); w.y = cvtpk(silu_f(g0[2]) * u0[2], silu_f(g0[3]) * u0[3]);
                w.z = cvtpk(silu_f(g1[0]) * u1[0], silu_f(g1[1]) * u1[1]); w.w = cvtpk(silu_f(g1[2]) * u1[2], silu_f(g1[3]) * u1[3]);
                *(GA1 u32x4*)p = w;
            }
    }
};
struct EpiRes {
    static constexpr bool PERM = true, AFTER_DRAIN = false;
    const bf16_t* XB; bf16_t* XW; float alpha; float* SSo;
    __device__ __forceinline__ void operator()(const f32x4 (&acc)[2][2][4][2], const pg8::Unit& u, int wr, int wc, int fr, int fq) const {
        const int row0 = u.pm * 256 + wr * 64 + fr, col0 = u.pn * 256 + wc * 32 + 8 * fq;
        const bf16_t* XB = this->XB; bf16_t* XW = this->XW; float alpha = this->alpha; float* SSo = this->SSo;
        asm volatile("" : "+s"(XB), "+s"(XW), "+s"(alpha), "+s"(SSo));
#pragma unroll
        for (int ai = 0; ai < 2; ++ai) {
            u32x4 bs[4][2];
#pragma unroll
            for (int m = 0; m < 4; ++m)
#pragma unroll
                for (int bj = 0; bj < 2; ++bj) bs[m][bj] = *(const GA1 u32x4*)(XB + (size_t)(row0 + ai * 128 + m * 16) * D + col0 + bj * 128);
#pragma unroll
            for (int m = 0; m < 4; ++m) {
                const int row = row0 + ai * 128 + m * 16;
                const size_t off = (size_t)row * D + col0;
                float ss = 0.f;
#pragma unroll
                for (int bj = 0; bj < 2; ++bj) { const size_t o = off + bj * 128; const u32x4 b = bs[m][bj];
                    const f32x4 v0 = (f32x4){bflo(b.x), bfhi(b.x), bflo(b.y), bfhi(b.y)} + alpha * acc[ai][bj][m][0], v1 = (f32x4){bflo(b.z), bfhi(b.z), bflo(b.w), bfhi(b.w)} + alpha * acc[ai][bj][m][1];
                    u32x4 w; w.x = cvtpk(v0[0], v0[1]); w.y = cvtpk(v0[2], v0[3]); w.z = cvtpk(v1[0], v1[1]); w.w = cvtpk(v1[2], v1[3]); *(GA1 u32x4*)(XW + o) = w;
                    ss += ((v0[0] * v0[0] + v0[1] * v0[1]) + (v0[2] * v0[2] + v0[3] * v0[3])) + ((v1[0] * v1[0] + v1[1] * v1[1]) + (v1[2] * v1[2] + v1[3] * v1[3])); }
                ss += __shfl_xor(ss, 16); ss += __shfl_xor(ss, 32); if (fq == 0) *(GA1 float*)(SSo + (size_t)row * 16 + u.pn * 4 + wc) = ss;
            }
        }
    }
};
struct EpiProj {
    static constexpr bool PERM = true, AFTER_DRAIN = false;
    bf16_t* O; float* LR; const float* SS;
    __device__ __forceinline__ void operator()(const f32x4 (&acc)[2][2][4][2], const pg8::Unit& u, int wr, int wc, int fr, int fq) const {
        const int row0 = u.pm * 256 + wr * 64 + fr;
        float rsv[2][4]; rows_rs(SS, row0, fq, rsv);
        if (u.pn >= 12) {
            if (wc == 0) {
#pragma unroll
                for (int ai = 0; ai < 2; ++ai)
#pragma unroll
                    for (int m = 0; m < 4; ++m) { const int row = row0 + ai * 128 + m * 16; const float rs = rsv[ai][m];
                        float* p = LR + (size_t)row * 32 + 8 * fq; *(GA1 f32x4*)p = acc[ai][0][m][0] * rs; *(GA1 f32x4*)(p + 4) = acc[ai][0][m][1] * rs; }
            }
            return;
        }
        const int col0 = u.pn * 256 + wc * 32 + 8 * fq;
#pragma unroll
        for (int ai = 0; ai < 2; ++ai)
#pragma unroll
            for (int m = 0; m < 4; ++m) {
                const int row = row0 + ai * 128 + m * 16; const float rs = rsv[ai][m];
                bf16_t* p = O + (size_t)row * PP + col0;
#pragma unroll
                for (int bj = 0; bj < 2; ++bj) { const f32x4 v0 = acc[ai][bj][m][0] * rs, v1 = acc[ai][bj][m][1] * rs; u32x4 w; w.x = cvtpk(v0[0], v0[1]); w.y = cvtpk(v0[2], v0[3]); w.z = cvtpk(v1[0], v1[1]); w.w = cvtpk(v1[2], v1[3]); *(GA1 u32x4*)(p + bj * 128) = w; }
            }
    }
};

__device__ __forceinline__ void tr_item(const float* W, int K, int N, bf16_t* WT, int mode, float sc, int sc_lo, int sc_hi, const float* gain, LAS float* scr, int item, int lane) {
    const int nblk = N / 32, kb = item / nblk, nb = item % nblk, k0 = 64 * kb, n0 = 32 * nb;
#pragma unroll 8
    for (int i = 0; i < 32; ++i) { const int kk = 2 * i + (lane >> 5); scr[kk * 33 + (lane & 31)] = W[(size_t)(k0 + kk) * N + n0 + (lane & 31)]; }
    asm volatile("s_waitcnt lgkmcnt(0)" ::: "memory");
    const int d0 = mode ? (256 * (n0 >> 7) + (n0 & 127) + (mode == 2 ? 128 : 0)) : n0;
    const float s = (n0 >= sc_lo && n0 < sc_hi) ? sc : 1.f;
    const int c = lane & 7;
    f32x4 ga = {s, s, s, s}, gb = {s, s, s, s};
    if (gain) { ga = ga * *(const GA1 f32x4*)(gain + k0 + 8 * c); gb = gb * *(const GA1 f32x4*)(gain + k0 + 8 * c + 4); }
#pragma unroll
    for (int j = 0; j < 4; ++j) { const int n = (lane >> 3) + 8 * j; const LAS float* p = scr + (8 * c) * 33 + n;
        u32x4 o; o.x = cvtpk(p[0 * 33] * ga[0], p[1 * 33] * ga[1]); o.y = cvtpk(p[2 * 33] * ga[2], p[3 * 33] * ga[3]); o.z = cvtpk(p[4 * 33] * gb[0], p[5 * 33] * gb[1]); o.w = cvtpk(p[6 * 33] * gb[2], p[7 * 33] * gb[3]);
        *(GA1 u32x4*)(WT + (size_t)(d0 + n) * K + k0 + 8 * c) = o; }
    asm volatile("s_waitcnt lgkmcnt(0)" ::: "memory");
}

template <bool OUT_F32>
__device__ __forceinline__ void norm_phase(const float* src, const float* gain, bf16_t* dst, float* dstf, int gw, int NGW, int lane) {
    f32x4 g[4];
#pragma unroll
    for (int j = 0; j < 4; ++j) g[j] = ((const f32x4*)gain)[lane + 64 * j];
    for (int m0 = gw; m0 < T; m0 += 4 * NGW) {
        f32x4 v[4][4]; float ss[4];
#pragma unroll
        for (int q = 0; q < 4; ++q) { const int m = m0 + q * NGW; const GA1 f32x4* xr = (const GA1 f32x4*)(src + (size_t)(m < T ? m : m0) * D) + lane;
#pragma unroll
            for (int j = 0; j < 4; ++j) v[q][j] = xr[64 * j]; }
#pragma unroll
        for (int q = 0; q < 4; ++q) { float a = 0.f;
#pragma unroll
            for (int j = 0; j < 4; ++j) a += (v[q][j].x * v[q][j].x + v[q][j].y * v[q][j].y) + (v[q][j].z * v[q][j].z + v[q][j].w * v[q][j].w);
            ss[q] = a; }
#pragma unroll
        for (int o = 1; o < 64; o <<= 1)
#pragma unroll
            for (int q = 0; q < 4; ++q) ss[q] += __shfl_xor(ss[q], o);
#pragma unroll
        for (int q = 0; q < 4; ++q) { const int m = m0 + q * NGW; if (m >= T) break;
            const float r = rsqrtf(ss[q] * (1.f / D) + EPS);
            if (OUT_F32) { GA1 f32x4* o = (GA1 f32x4*)(dstf + (size_t)m * D) + lane;
#pragma unroll
                for (int j = 0; j < 4; ++j) o[64 * j] = v[q][j] * r * g[j];
            } else { GA1 u32x2* o = (GA1 u32x2*)(dst + (size_t)m * D) + lane;
#pragma unroll
                for (int j = 0; j < 4; ++j) { const f32x4 y = v[q][j] * r * g[j]; u32x2 w; w.x = cvtpk(y.x, y.y); w.y = cvtpk(y.z, y.w); o[64 * j] = w; } }
        }
    }
}

__device__ __forceinline__ void final_phase(const bf16_t* src, const float* SS, const float* gain, float* dstf, int gw, int NGW, int lane) {
    f32x4 g[4];
#pragma unroll
    for (int j = 0; j < 4; ++j) g[j] = ((const f32x4*)gain)[lane * 4 + j];
    for (int m0 = gw; m0 < T; m0 += 4 * NGW) {
        u32x4 v[4][2]; float pr[4];
#pragma unroll
        for (int q = 0; q < 4; ++q) { const int m = (m0 + q * NGW) < T ? (m0 + q * NGW) : m0; const GA1 u32x4* xr = (const GA1 u32x4*)(src + (size_t)m * D + lane * 16); v[q][0] = xr[0]; v[q][1] = xr[1];
            pr[q] = SS[(size_t)m * 16 + (lane & 15)]; }
#pragma unroll
        for (int q = 0; q < 4; ++q) { float a = pr[q]; a += __shfl_xor(a, 1); a += __shfl_xor(a, 2); a += __shfl_xor(a, 4); a += __shfl_xor(a, 8); pr[q] = rsqrtf(a * (1.f / D) + EPS); }
#pragma unroll
        for (int q = 0; q < 4; ++q) { const int m = m0 + q * NGW; if (m >= T) break;
            GA1 f32x4* o = (GA1 f32x4*)(dstf + (size_t)m * D + lane * 16); const float r = pr[q];
#pragma unroll
            for (int c = 0; c < 2; ++c) { const u32x4 b = v[q][c];
                o[2 * c] = (f32x4){bflo(b.x), bfhi(b.x), bflo(b.y), bfhi(b.y)} * r * g[2 * c]; o[2 * c + 1] = (f32x4){bflo(b.z), bfhi(b.z), bflo(b.w), bfhi(b.w)} * r * g[2 * c + 1]; }
        }
    }
}

__device__ __forceinline__ void cast_phase(const float* src, bf16_t* dst, float* SSo, int gw, int NGW, int lane) {
    for (int m0 = gw; m0 < T; m0 += 4 * NGW) {
        f32x4 v[4][4]; float ss[4];
#pragma unroll
        for (int q = 0; q < 4; ++q) { const int m = m0 + q * NGW; const GA1 f32x4* xr = (const GA1 f32x4*)(src + (size_t)(m < T ? m : m0) * D) + lane;
#pragma unroll
            for (int j = 0; j < 4; ++j) v[q][j] = xr[64 * j]; }
#pragma unroll
        for (int q = 0; q < 4; ++q) { float a = 0.f;
#pragma unroll
            for (int j = 0; j < 4; ++j) a += (v[q][j].x * v[q][j].x + v[q][j].y * v[q][j].y) + (v[q][j].z * v[q][j].z + v[q][j].w * v[q][j].w);
            ss[q] = a; }
#pragma unroll
        for (int o = 1; o < 64; o <<= 1)
#pragma unroll
            for (int q = 0; q < 4; ++q) ss[q] += __shfl_xor(ss[q], o);
#pragma unroll
        for (int q = 0; q < 4; ++q) { const int m = m0 + q * NGW; if (m >= T) break;
            GA1 u32x2* o = (GA1 u32x2*)(dst + (size_t)m * D) + lane;
#pragma unroll
            for (int j = 0; j < 4; ++j) { u32x2 w; w.x = cvtpk(v[q][j].x, v[q][j].y); w.y = cvtpk(v[q][j].z, v[q][j].w); o[64 * j] = w; }
            if (lane < 16) SSo[(size_t)m * 16 + lane] = lane == 0 ? ss[q] : 0.f; }
    }
}

__device__ __forceinline__ void prep0_phase(bf16_t* P, const int* pos, const float* logit_f, const float* logit_b, bf16_t* QGf, bf16_t* KGf, bf16_t* QGb, bf16_t* KGb,
                                            float* DECf, float* DECb, int gw, int NGW, int lane) {
    const int fa = lane & 7, fr_ = lane & 31, hh = lane >> 5;
    const float inva = exp2f(-18.931568569324174f * (float)(2 * fa) * (1.f / 16.f));
    const float invr = exp2f(-13.287712379549449f * (float)(2 * fr_) * (1.f / 64.f));
    float lgf[4], lgb[4];
#pragma unroll
    for (int h = 0; h < 4; ++h) { lgf[h] = logsig(logit_f[h]); lgb[h] = logsig(logit_b[h]); }
    for (int m = gw; m < T; m += NGW) {
        const int b = m >> 12, s = m & 4095, c = s & 63;
        const float posf = (float)pos[s];
        bf16_t* row = P + (size_t)m * PP;
        unsigned short ar[2][2], rr[4][2];
#pragma unroll
        for (int i = 0; i < 2; ++i) { const int col = i * 512 + (lane >> 3) * 64 + fa; ar[i][0] = *(const GA1 bf16_t*)(row + col); ar[i][1] = *(const GA1 bf16_t*)(row + col + 8); }
#pragma unroll
        for (int i = 0; i < 4; ++i) { const int which = i >> 1, head = ((i & 1) << 1) | hh, col = 1536 + which * 256 + head * 64 + fr_; rr[i][0] = *(const GA1 bf16_t*)(row + col); rr[i][1] = *(const GA1 bf16_t*)(row + col + 32); }
        {
            float sn, cs; sincos_rev(posf * inva, sn, cs);
#pragma unroll
            for (int i = 0; i < 2; ++i) { const int col = i * 512 + (lane >> 3) * 64 + fa; const float x1 = bf2f(ar[i][0]), x2 = bf2f(ar[i][1]);
                *(GA1 bf16_t*)(row + col) = f2bf(x1 * cs - x2 * sn); *(GA1 bf16_t*)(row + col + 8) = f2bf(x1 * sn + x2 * cs); }
        }
        {
            float sn, cs; sincos_rev(posf * invr, sn, cs);
#pragma unroll
            for (int i = 0; i < 4; ++i) {
                const int which = i >> 1, head = ((i & 1) << 1) | hh;
                const float lf = hh ? lgf[((i & 1) << 1) | 1] : lgf[(i & 1) << 1], lb = hh ? lgb[((i & 1) << 1) | 1] : lgb[(i & 1) << 1];
                const float x1 = bf2f(rr[i][0]), x2 = bf2f(rr[i][1]);
                const float ksc = which ? 0.125f : 1.f;
                const float y1 = (x1 * cs - x2 * sn) * ksc, y2 = (x1 * sn + x2 * cs) * ksc;
                float ef = lf * (float)(c + 1), eb = lb * (float)(64 - c);
                if (which) { ef = -ef; eb = -eb; }
                const float gf = expf(ef), gb = expf(eb);
                const size_t o = (size_t)m * 256 + head * 64 + fr_;
                bf16_t* df = which ? KGf : QGf; bf16_t* db = which ? KGb : QGb;
                *(GA1 bf16_t*)(df + o) = f2bf(y1 * gf); *(GA1 bf16_t*)(df + o + 32) = f2bf(y2 * gf); *(GA1 bf16_t*)(db + o) = f2bf(y1 * gb); *(GA1 bf16_t*)(db + o + 32) = f2bf(y2 * gb);
            }
        }
        if (c == 0) {
            const int n = s >> 6;
#pragma unroll
            for (int e8 = 0; e8 < 8; ++e8) { const int e = lane + 64 * e8, dir = e >> 8, hd = (e >> 6) & 3, d = e & 63;
                const float lg = dir ? (hd == 0 ? lgb[0] : hd == 1 ? lgb[1] : hd == 2 ? lgb[2] : lgb[3]) : (hd == 0 ? lgf[0] : hd == 1 ? lgf[1] : hd == 2 ? lgf[2] : lgf[3]);
                (dir ? DECb : DECf)[((size_t)(b * 4 + hd) * 64 + n) * 64 + d] = expf(lg * 64.f); }
        }
    }
}

__device__ __forceinline__ void prep1_phase(const bf16_t* P, const float* LR, const float* w2f, const float* bf_, const float* w2b, const float* bb_, bf16_t* QGf, bf16_t* KGf, bf16_t* QGb, bf16_t* KGb,
                                            float* DECf, float* DECb, int tid, LAS unsigned char* lds, int bid, int G) {
    const int ch = tid & 127, tg = __builtin_amdgcn_readfirstlane(tid >> 7);
    LAS float* tot = (LAS float*)lds;
    LAS float* lrs = (LAS float*)(lds + 4096);
    typedef float f32x2v __attribute__((ext_vector_type(2)));
    f32x2v lrv; unsigned short qraw[16], kraw[16];
    float wcol[16]; float bias = 0.f; int key = -1;
#define P1_LOADS(IT, LV, QR, KR) do { const int dir_ = (IT) & 1, h_ = ((IT) >> 1) & 3, chunk_ = ((IT) >> 3) & 63, b_ = (IT) >> 9; const size_t tb_ = (size_t)b_ * SEQ + chunk_ * 64; \
        LV = *(const GA1 f32x2v*)(LR + (tb_ + (tid >> 3)) * 32 + dir_ * 16 + (tid & 7) * 2); \
        _Pragma("unroll") for (int i_ = 0; i_ < 16; ++i_) { QR[i_] = *(const GA1 bf16_t*)(P + (tb_ + tg * 16 + i_) * PP + h_ * 128 + ch); KR[i_] = *(const GA1 bf16_t*)(P + (tb_ + tg * 16 + i_) * PP + 512 + h_ * 128 + ch); } } while (0)
    if (bid < 4096) P1_LOADS(bid, lrv, qraw, kraw);
#pragma unroll 1
    for (int it = bid; it < 4096; it += G) {
        const int dir = it & 1, h = (it >> 1) & 3, chunk = (it >> 3) & 63, b = it >> 9;
        if ((it & 7) != key) {
            const float* w2 = dir ? w2b : w2f;
#pragma unroll
            for (int r = 0; r < 16; ++r) wcol[r] = *(const GA1 float*)(w2 + r * 512 + h * 128 + ch);
            bias = *(const GA1 float*)((dir ? bb_ : bf_) + h * 128 + ch); key = it & 7;
        }
        bf16_t* QG = dir ? QGb : QGf; bf16_t* KG = dir ? KGb : KGf;
        const size_t t0 = (size_t)b * SEQ + chunk * 64 + tg * 16;
        *(LAS f32x2v*)(lrs + (tid >> 3) * 16 + (tid & 7) * 2) = lrv;
        __syncthreads();
        f32x2v nlrv = lrv; unsigned short nq[16], nk[16];
#pragma unroll
        for (int i = 0; i < 16; ++i) { nq[i] = qraw[i]; nk[i] = kraw[i]; }
        if (it + G < 4096) P1_LOADS(it + G, nlrv, nq, nk);
        float cum[16];
#pragma unroll
        for (int i = 0; i < 16; ++i) {
            const LAS f32x4* lr = (const LAS f32x4*)(lrs + (tg * 16 + i) * 16);
            const f32x4 l0 = lr[0], l1 = lr[1], l2 = lr[2], l3 = lr[3];
            float z = bias;
            z += l0[0] * wcol[0] + l0[1] * wcol[1] + l0[2] * wcol[2] + l0[3] * wcol[3];
            z += l1[0] * wcol[4] + l1[1] * wcol[5] + l1[2] * wcol[6] + l1[3] * wcol[7];
            z += l2[0] * wcol[8] + l2[1] * wcol[9] + l2[2] * wcol[10] + l2[3] * wcol[11];
            z += l3[0] * wcol[12] + l3[1] * wcol[13] + l3[2] * wcol[14] + l3[3] * wcol[15];
            { const float e = __builtin_amdgcn_exp2f(-fabsf(z) * 1.4426950408889634f);
              cum[i] = (fminf(z, 0.f) * 1.4426950408889634f - __builtin_amdgcn_logf(1.f + e)) * (1.f / 16.f); }
        }
        float total;
        if (!dir) {
#pragma unroll
            for (int i = 1; i < 16; ++i) cum[i] += cum[i - 1];
            total = cum[15];
        } else {
#pragma unroll
            for (int i = 14; i >= 0; --i) cum[i] += cum[i + 1];
            total = cum[0];
        }
        tot[tg * 128 + ch] = total;
        __syncthreads();
        const float s0 = tot[ch], s1 = tot[128 + ch], s2 = tot[256 + ch], s3 = tot[384 + ch];
        float off;
        if (!dir) off = tg == 0 ? 0.f : tg == 1 ? s0 : tg == 2 ? s0 + s1 : (s0 + s1) + s2;
        else off = tg == 3 ? 0.f : tg == 2 ? s3 : tg == 1 ? s3 + s2 : (s3 + s2) + s1;
#pragma unroll
        for (int i = 0; i < 16; ++i) {
            const float c = cum[i] + off;
            const float qv = bf2f(qraw[i]), kv = bf2f(kraw[i]);
            *(GA1 bf16_t*)(QG + (t0 + i) * 512 + h * 128 + ch) = f2bf(qv * __builtin_amdgcn_exp2f(c));
            *(GA1 bf16_t*)(KG + (t0 + i) * 512 + h * 128 + ch) = f2bf(kv * __builtin_amdgcn_exp2f(-c));
        }
        if (tg == 0) *(GA1 float*)((dir ? DECb : DECf) + ((size_t)(b * 4 + h) * 64 + chunk) * 128 + ch) = __builtin_amdgcn_exp2f((s0 + s1) + (s2 + s3));
        lrv = nlrv;
#pragma unroll
        for (int i = 0; i < 16; ++i) { qraw[i] = nq[i]; kraw[i] = nk[i]; }
    }
#undef P1_LOADS
}
#define XB_TMO      128
#define XB_XCNT(j)  (256  + 64 * (j))
#define XB_XSUB(j)  (1280 + 64 * (j))
#define XB_XGEN(j)  (2304 + 64 * (j))
#define XB_TOP      3328
#define XB_TOPGEN   3392
#define XCD_BAR_WORDS 3456
#define XB_SPIN_CAP (1u << 18)

__device__ __forceinline__ unsigned xb_ld(unsigned* p)              { return __hip_atomic_load(p, __ATOMIC_RELAXED, __HIP_MEMORY_SCOPE_AGENT); }
__device__ __forceinline__ unsigned xb_add(unsigned* p, unsigned v) { return __hip_atomic_fetch_add(p, v, __ATOMIC_RELAXED, __HIP_MEMORY_SCOPE_AGENT); }
__device__ __forceinline__ unsigned xb_xcc_id() { return (unsigned)__builtin_amdgcn_s_getreg((3 << 11) | 20) & 0xFu; }
#define XB_SPIN(cond, bar) do { unsigned _sp = 0; while (cond) { __builtin_amdgcn_s_sleep(1); \
    if ((++_sp & 255u) == 0u) { if (xb_ld(&(bar)[XB_TMO])) break; if (_sp > XB_SPIN_CAP) { atomicAdd(&(bar)[XB_TMO], 1u); break; } } } } while (0)

struct XcdBarrier {
    unsigned* bar; unsigned x;
    volatile LAS unsigned* st;
};

__device__ __forceinline__ XcdBarrier xcd_barrier_post(unsigned* bar, volatile LAS unsigned* st) {
    XcdBarrier b; b.bar = bar; b.x = xb_xcc_id(); b.st = st;
    if (threadIdx.x == 0) (void)xb_add(&bar[XB_XCNT(b.x)], 1u);
    return b;
}
__device__ __forceinline__ void xcd_barrier_complete(unsigned* bar, unsigned x, unsigned& nloc, unsigned& nx) {
    const unsigned G = gridDim.x * gridDim.y * gridDim.z;
    unsigned sum, cnt, mine, sp = 0u;
    for (;;) {
        sum = 0u; cnt = 0u; mine = 0u;
#pragma unroll
        for (unsigned j = 0; j < 16; ++j) { const unsigned c = xb_ld(&bar[XB_XCNT(j)]); sum += c; cnt += (c > 0u) ? 1u : 0u; mine = (j == x) ? c : mine; }
        if (sum == G) break;
        __builtin_amdgcn_s_sleep(1);
        if ((++sp & 255u) == 0u) { if (xb_ld(&bar[XB_TMO])) break; if (sp > XB_SPIN_CAP) { atomicAdd(&bar[XB_TMO], 1u); break; } }
    }
    nloc = mine > 0u ? mine : 1u; nx = cnt > 0u ? cnt : 1u;
}

__device__ __forceinline__ void xcd_barrier(const XcdBarrier& b) {
    asm volatile("s_waitcnt vmcnt(0)" ::: "memory");
    __syncthreads();
    if (threadIdx.x == 0) {
        unsigned* bar = b.bar;
        __builtin_amdgcn_s_waitcnt(0);
        unsigned nloc = b.st[0], nx = b.st[1];
        if (nloc == 0u) { xcd_barrier_complete(bar, b.x, nloc, nx); b.st[0] = nloc; b.st[1] = nx; }
        const unsigned old = xb_add(&bar[XB_XSUB(b.x)], 1u);
        const unsigned gen = old / nloc;
        if (old + 1u == (gen + 1u) * nloc) {
            __builtin_amdgcn_fence(__ATOMIC_RELEASE, "agent");
            asm volatile("s_waitcnt vmcnt(0)" ::: "memory");
            const unsigned og = xb_add(&bar[XB_TOP], 1u);
            const unsigned tg = og / nx;
            if (og + 1u == (tg + 1u) * nx) xb_add(&bar[XB_TOPGEN], 1u);
            else XB_SPIN(xb_ld(&bar[XB_TOPGEN]) == tg, bar);
            __builtin_amdgcn_fence(__ATOMIC_ACQUIRE, "agent");
            xb_add(&bar[XB_XGEN(b.x)], 1u);
            asm volatile("s_waitcnt vmcnt(0)" ::: "memory");
        } else {
            XB_SPIN(xb_ld(&bar[XB_XGEN(b.x)]) == gen, bar);
            __builtin_amdgcn_fence(__ATOMIC_ACQUIRE, "agent");
            asm volatile("s_waitcnt vmcnt(0)" ::: "memory");
        }
    }
    __syncthreads();
}
#ifndef AT_VALU_MASK
#define AT_VALU_MASK 0x002
#endif
constexpr int AT_KP = 272, AT_VP = 320, AT_KB = 64 * AT_KP, AT_VB = 64 * AT_VP, AT_TB = AT_KB + AT_VB;
__device__ __forceinline__ void attn_unit(LAS unsigned char* lds, const bf16_t* P, bf16_t* cat, int b, int h, int qb, float lam, const float* da_norm, float post_scale) {
    int tid_ = threadIdx.x; asm volatile("" : "+v"(tid_)); const int tid = tid_, lane = tid & 63, w = __builtin_amdgcn_readfirstlane(tid >> 6), r32 = lane & 31, hi = lane >> 5;
    const int comp = w >> 2, qs = w & 3, i16 = lane & 15, qq = i16 >> 2, pp = i16 & 3, blk = (lane >> 4) & 1;
    const size_t rowb = (size_t)b * SEQ;
    const bf16_t* qp = P + (rowb + qb * 128 + qs * 32 + r32) * PP + h * 128 + comp * 64 + hi * 8;
    LAS unsigned char* Qs = lds + 2 * AT_KB + 2 * AT_VB + (w * 4 * 64 + lane) * 16;
#pragma unroll
    for (int s = 0; s < 4; ++s) *(LAS bf16x8*)(Qs + s * 1024) = *(const GA1 bf16x8*)(qp + 16 * s);
    const int srow = tid >> 4, sch = tid & 15;
    const bf16_t* kg = P + (rowb + srow) * PP + 512 + h * 128 + sch * 8;
    const bf16_t* vg = P + (rowb + srow) * PP + 1024 + h * 128 + sch * 8;
    u32x4 kr0, kr1, vr0, vr1;
#define AT_LOADK(t) do { const size_t o_ = (size_t)(t) * 64 * PP; kr0 = *(const GA1 u32x4*)(kg + o_); kr1 = *(const GA1 u32x4*)(kg + o_ + 32 * PP); } while (0)
#define AT_LOADV(t) do { const size_t o_ = (size_t)(t) * 64 * PP; vr0 = *(const GA1 u32x4*)(vg + o_); vr1 = *(const GA1 u32x4*)(vg + o_ + 32 * PP); } while (0)
#define AT_STOREK(bufi) do { LAS unsigned char* kb_ = lds + (bufi) * AT_KB; *(LAS u32x4*)(kb_ + srow * AT_KP + sch * 16) = kr0; *(LAS u32x4*)(kb_ + (srow + 32) * AT_KP + sch * 16) = kr1; } while (0)
#define AT_STOREV(bufi) do { LAS unsigned char* vb_ = lds + 2 * AT_KB + (bufi) * AT_VB; *(LAS u32x4*)(vb_ + srow * AT_VP + sch * 16) = vr0; *(LAS u32x4*)(vb_ + (srow + 32) * AT_VP + sch * 16) = vr1; } while (0)
#define AT_QK(bufi) do { const LAS unsigned char* Kc = lds + (bufi) * AT_KB; bf16x8 ka[4], kb_[4]; \
        _Pragma("unroll") for (int s = 0; s < 4; ++s) { ka[s] = *(const LAS bf16x8*)(Kc + r32 * AT_KP + comp * 128 + s * 32 + hi * 16); kb_[s] = *(const LAS bf16x8*)(Kc + (32 + r32) * AT_KP + comp * 128 + s * 32 + hi * 16); } \
        _Pragma("unroll") for (int r_ = 0; r_ < 16; ++r_) { s0[r_] = nmh; s1[r_] = nmh; } \
        _Pragma("unroll") for (int s = 0; s < 4; ++s) { const bf16x8 qv_ = *(const LAS bf16x8*)(Qs + s * 1024); s0 = __builtin_amdgcn_mfma_f32_32x32x16_bf16(ka[s], qv_, s0, 0, 0, 0); s1 = __builtin_amdgcn_mfma_f32_32x32x16_bf16(kb_[s], qv_, s1, 0, 0, 0); } } while (0)
#define AT_PV(bufi) do { const LAS unsigned char* vb0 = lds + 2 * AT_KB + (bufi) * AT_VB + (4 * hi + qq) * AT_VP + (16 * blk + 4 * pp) * 2; \
        _Pragma("unroll") for (int vb = 0; vb < 4; ++vb) { s16x4 vf_[8]; \
            _Pragma("unroll") for (int kb = 0; kb < 2; ++kb) _Pragma("unroll") for (int s2 = 0; s2 < 2; ++s2) { const LAS unsigned char* ad = vb0 + (kb * 32 + 16 * s2) * AT_VP + vb * 64; vf_[(kb * 2 + s2) * 2] = vtr(ad); vf_[(kb * 2 + s2) * 2 + 1] = vtr(ad + 8 * AT_VP); } \
            __builtin_amdgcn_sched_barrier(0); \
            _Pragma("unroll") for (int kb = 0; kb < 2; ++kb) _Pragma("unroll") for (int s2 = 0; s2 < 2; ++s2) \
                o[vb] = __builtin_amdgcn_mfma_f32_32x32x16_bf16(cat8(vf_[(kb * 2 + s2) * 2], vf_[(kb * 2 + s2) * 2 + 1]), __builtin_bit_cast(bf16x8, pw[kb][s2]), o[vb], 0, 0, 0); \
            __builtin_amdgcn_sched_barrier(0); } } while (0)
#define AT_PACK(dst) do { _Pragma("unroll") for (int s2 = 0; s2 < 2; ++s2) { \
            dst[0][s2] = (u32x4){cvtpk(s0[8 * s2 + 0], s0[8 * s2 + 1]), cvtpk(s0[8 * s2 + 2], s0[8 * s2 + 3]), cvtpk(s0[8 * s2 + 4], s0[8 * s2 + 5]), cvtpk(s0[8 * s2 + 6], s0[8 * s2 + 7])}; \
            dst[1][s2] = (u32x4){cvtpk(s1[8 * s2 + 0], s1[8 * s2 + 1]), cvtpk(s1[8 * s2 + 2], s1[8 * s2 + 3]), cvtpk(s1[8 * s2 + 4], s1[8 * s2 + 5]), cvtpk(s1[8 * s2 + 6], s1[8 * s2 + 7])}; } } while (0)
    if (w >= 4) __builtin_amdgcn_s_setprio(1);
    {
        const u32x4 k1a = *(const GA1 u32x4*)(kg + (size_t)64 * PP), k1b = *(const GA1 u32x4*)(kg + (size_t)64 * PP + 32 * PP);
        AT_LOADK(0); AT_LOADV(0); AT_STOREK(0); AT_STOREV(0);
        kr0 = k1a; kr1 = k1b; AT_STOREK(1);
    }
    __syncthreads();
    f32x16 o[4];
#pragma unroll
    for (int v = 0; v < 4; ++v)
#pragma unroll
        for (int r = 0; r < 16; ++r) o[v][r] = 0.f;
    float mhat = 0.f, l_run = 0.f, nmh = 0.f;
    f32x16 s0, s1;
    u32x4 pw[2][2];
    {
        AT_QK(0);
        float mx = fmaxf(fmaxf(s0[0], s1[0]), fmaxf(s0[1], s1[1]));
#pragma unroll
        for (int r = 2; r < 16; r += 2) mx = fmaxf(fmaxf(mx, fmaxf(s0[r], s1[r])), fmaxf(s0[r + 1], s1[r + 1]));
        mx = fmaxf(mx, __shfl_xor(mx, 32));
        mhat = mx;
        float psum = 0.f;
        nmh = -mhat;
#pragma unroll
        for (int r = 0; r < 16; ++r) { s0[r] = __builtin_amdgcn_exp2f(s0[r] - mx); s1[r] = __builtin_amdgcn_exp2f(s1[r] - mx); psum += s0[r] + s1[r]; }
        l_run = psum;
        AT_PACK(pw);
    }
    for (int t = 0; t < 63; ++t) {
        if (t + 2 < 64) AT_LOADK(t + 2);
        AT_LOADV(t + 1);
        AT_QK((t + 1) & 1);
        asm volatile("" : "+v"(s0), "+v"(s1) :: "memory");
        float psum = 0.f;
        u32x4 pwn[2][2];
        {
            const LAS unsigned char* vb0 = lds + 2 * AT_KB + (t & 1) * AT_VB + (4 * hi + qq) * AT_VP + (16 * blk + 4 * pp) * 2;
            s16x4 vfa[2][8];
#define AT_VRD(buf, vb) do { _Pragma("unroll") for (int kb = 0; kb < 2; ++kb) _Pragma("unroll") for (int s2 = 0; s2 < 2; ++s2) { \
                const LAS unsigned char* ad = vb0 + (kb * 32 + 16 * s2) * AT_VP + (vb) * 64; vfa[buf][(kb * 2 + s2) * 2] = vtr(ad); vfa[buf][(kb * 2 + s2) * 2 + 1] = vtr(ad + 8 * AT_VP); } } while (0)
            AT_VRD(0, 0);
#pragma unroll
            for (int vb = 0; vb < 4; ++vb) {
                if (vb < 3) AT_VRD((vb + 1) & 1, vb + 1);
                __builtin_amdgcn_sched_barrier(0);
#pragma unroll
                for (int q4 = 0; q4 < 4; ++q4) {
                    const int i = vb * 4 + q4, kb = q4 >> 1, s2 = q4 & 1;
                    o[vb] = __builtin_amdgcn_mfma_f32_32x32x16_bf16(cat8(vfa[vb & 1][(kb * 2 + s2) * 2], vfa[vb & 1][(kb * 2 + s2) * 2 + 1]), __builtin_bit_cast(bf16x8, pw[kb][s2]), o[vb], 0, 0, 0);
                    float e0, e1;
                    if (i < 8) { e0 = __builtin_amdgcn_exp2f(s0[2 * i]); e1 = __builtin_amdgcn_exp2f(s0[2 * i + 1]); s0[2 * i] = e0; s0[2 * i + 1] = e1; }
                    else { e0 = __builtin_amdgcn_exp2f(s1[2 * (i - 8)]); e1 = __builtin_amdgcn_exp2f(s1[2 * (i - 8) + 1]); s1[2 * (i - 8)] = e0; s1[2 * (i - 8) + 1] = e1; }
                    psum += e0 + e1;
                    pwn[i >> 3][(i >> 2) & 1][i & 3] = cvtpk(e0, e1);
                    asm volatile("" : "+v"(psum), "+v"(o[vb]) :: "memory");
                    __builtin_amdgcn_sched_barrier(0);
                }
            }
#undef AT_VRD
        }
        if (__any(psum > 4096.f)) {
            float pm = fmaxf(fmaxf(s0[0], s1[0]), fmaxf(s0[1], s1[1]));
#pragma unroll
            for (int r = 2; r < 16; r += 2) pm = fmaxf(fmaxf(pm, fmaxf(s0[r], s1[r])), fmaxf(s0[r + 1], s1[r + 1]));
            pm = fmaxf(pm, __shfl_xor(pm, 32));
            const float dl = fmaxf(__builtin_amdgcn_logf(pm), 0.f), f = __builtin_amdgcn_exp2f(-dl);
            mhat += dl; psum *= f; l_run *= f;
            nmh = -mhat;
#pragma unroll
            for (int r = 0; r < 16; ++r) { s0[r] *= f; s1[r] *= f; }
#pragma unroll
            for (int v = 0; v < 4; ++v)
#pragma unroll
                for (int r = 0; r < 16; ++r) o[v][r] *= f;
            AT_PACK(pwn);
        }
        l_run += psum;
#pragma unroll
        for (int a_ = 0; a_ < 2; ++a_)
#pragma unroll
            for (int b_ = 0; b_ < 2; ++b_) pw[a_][b_] = pwn[a_][b_];
        if (t + 2 < 64) AT_STOREK(t & 1);
        AT_STOREV((t + 1) & 1);
        __syncthreads();
    }
    AT_PV(1);
    __builtin_amdgcn_s_setprio(0);
    __syncthreads();
#undef AT_LOADK
#undef AT_LOADV
#undef AT_STOREK
#undef AT_STOREV
#undef AT_QK
#undef AT_PV
#undef AT_PACK
    const float l = l_run + __shfl_xor(l_run, 32), inv = 1.f / l;
    LAS float* ex = (LAS float*)lds;
    if (comp == 1) {
#pragma unroll
        for (int v = 0; v < 4; ++v)
#pragma unroll
            for (int r = 0; r < 16; ++r) ex[(v * 16 + r) * 256 + qs * 64 + lane] = o[v][r] * inv;
    }
    __syncthreads();
    if (comp == 0) {
        float ss = 0.f;
#pragma unroll
        for (int v = 0; v < 4; ++v)
#pragma unroll
            for (int r = 0; r < 16; ++r) { const float d = o[v][r] * inv - lam * ex[(v * 16 + r) * 256 + qs * 64 + lane]; o[v][r] = d; ss += d * d; }
        ss += __shfl_xor(ss, 32);
        const float rs = rsqrtf(ss * (1.f / 128.f) + EPS) * post_scale;
        bf16_t* op = cat + (rowb + qb * 128 + qs * 32 + r32) * D + h * 128;
        f32x4 gnv[4][4];
#pragma unroll
        for (int v = 0; v < 4; ++v)
#pragma unroll
            for (int g = 0; g < 4; ++g) gnv[v][g] = *(const GA1 f32x4*)(da_norm + v * 32 + 8 * g + 4 * hi);
#pragma unroll
        for (int v = 0; v < 4; ++v)
#pragma unroll
            for (int gp = 0; gp < 4; gp += 2) {
                const f32x4 ga = gnv[v][gp], gb = gnv[v][gp + 1];
                const unsigned ax = cvtpk(o[v][4 * gp] * rs * ga[0], o[v][4 * gp + 1] * rs * ga[1]), ay = cvtpk(o[v][4 * gp + 2] * rs * ga[2], o[v][4 * gp + 3] * rs * ga[3]);
                const unsigned bx = cvtpk(o[v][4 * gp + 4] * rs * gb[0], o[v][4 * gp + 5] * rs * gb[1]), by = cvtpk(o[v][4 * gp + 6] * rs * gb[2], o[v][4 * gp + 7] * rs * gb[3]);
                const auto r0 = __builtin_amdgcn_permlane32_swap(ax, bx, false, false), r1 = __builtin_amdgcn_permlane32_swap(ay, by, false, false);
                const u32x4 w4 = {r0[0], r1[0], r0[1], r1[1]};
                *(GA1 u32x4*)(op + v * 32 + 8 * (gp + hi)) = w4; }
    }
    __syncthreads();
}

#define GAS __attribute__((address_space(1)))
template <int DK>
__device__ __forceinline__ void walk_unit(LAS unsigned char* lds, const bf16_t* QG, const bf16_t* KG, int h, const bf16_t* Vp, const float* dec, bf16_t* Op, int opitch, int b, int dir) {
    constexpr int PQ = DK * 2 + 16, PV = 144, NCH = DK / 8, QB = 64 * PQ, VB = 64 * PV, TB = 2 * QB + VB, ST0 = 2 * TB, STB = 64 * PQ, NQ = 64 * NCH / 512, QPITCH = 4 * DK;
    static_assert(ST0 + 2 * STB <= 131072, "walk LDS");
    int tid_ = threadIdx.x; asm volatile("" : "+v"(tid_)); const int tid = tid_, lane = tid & 63, w = __builtin_amdgcn_readfirstlane(tid >> 6), r32 = lane & 31, hi = lane >> 5;
    const int i16 = lane & 15, qq = i16 >> 2, pp = i16 & 3, blk = (lane >> 4) & 1;
    u32x4 qreg[2][NQ], kreg[2][NQ], vreg[2];
    const int vrow = tid >> 3, vch = tid & 7;
#define WK_LOAD(set, n) do { const size_t t0_ = (size_t)b * SEQ + (size_t)(n) * 64; \
        _Pragma("unroll") for (int i_ = 0; i_ < NQ; ++i_) { const int id_ = tid + 512 * i_, row_ = id_ / NCH, ch_ = id_ % NCH; const size_t go_ = (t0_ + row_) * QPITCH + h * DK + ch_ * 8; \
            qreg[set][i_] = *(const GAS u32x4*)(QG + go_); kreg[set][i_] = *(const GAS u32x4*)(KG + go_); } \
        vreg[set] = *(const GAS u32x4*)(Vp + (t0_ + vrow) * PP + vch * 8); } while (0)
#define WK_STORE(set, bufi) do { LAS unsigned char* q_ = lds + (bufi) * TB; \
        _Pragma("unroll") for (int i_ = 0; i_ < NQ; ++i_) { const int id_ = tid + 512 * i_, row_ = id_ / NCH, ch_ = id_ % NCH; \
            *(LAS u32x4*)(q_ + row_ * PQ + ch_ * 16) = qreg[set][i_]; *(LAS u32x4*)(q_ + QB + row_ * PQ + ch_ * 16) = kreg[set][i_]; } \
        *(LAS u32x4*)(q_ + 2 * QB + vrow * PV + vch * 16) = vreg[set]; } while (0)
    constexpr int NB = DK / 64, NS = DK / 16;
    f32x16 sacc[NB];
#pragma unroll
    for (int j = 0; j < NB; ++j)
#pragma unroll
        for (int r = 0; r < 16; ++r) sacc[j][r] = 0.f;
    for (int e = tid; e < STB / 16; e += 512) *(LAS u32x4*)(lds + ST0 + e * 16) = (u32x4){0u, 0u, 0u, 0u};
    WK_LOAD(0, dir ? 63 : 0); WK_STORE(0, 0); WK_LOAD(0, dir ? 62 : 1); WK_LOAD(1, dir ? 61 : 2);
    const int dsd = (NB == 2 ? ((w - 4) & 3) : (((w - 4) & 3) >> 1)) * 32 + r32;
    float dl_next = *(const GAS float*)(dec + (size_t)(dir ? 63 : 0) * DK + dsd);
    __syncthreads();
    for (int i2 = 0; i2 < 64; i2 += 2)
#pragma unroll
    for (int u_ = 0; u_ < 2; ++u_) {
        const int i = i2 + u_;
        const int n = dir ? 63 - i : i;
        const float dl = dl_next;
        if (i < 63) dl_next = *(const GAS float*)(dec + (size_t)(dir ? n - 1 : n + 1) * DK + dsd);
        const size_t t0 = (size_t)b * SEQ + (size_t)n * 64;
        const LAS unsigned char* Qs = lds + u_ * TB; const LAS unsigned char* Ks = Qs + QB; const LAS unsigned char* Vs = Ks + QB;
        const LAS unsigned char* STc = lds + ST0 + u_ * STB; LAS unsigned char* STn = lds + ST0 + (u_ ^ 1) * STB;
        if (w < 4) {
            const int cb = w & 1, vb = w >> 1;
            f32x16 pt0, pt1, oacc;
#pragma unroll
            for (int r = 0; r < 16; ++r) { pt0[r] = 0.f; pt1[r] = 0.f; oacc[r] = 0.f; }
            const LAS unsigned char* vb0 = Vs + (4 * hi + qq) * PV + (vb * 32 + 16 * blk + 4 * pp) * 2;
            s16x4 vf[8];
#pragma unroll
            for (int jb = 0; jb < 2; ++jb)
#pragma unroll
                for (int s2 = 0; s2 < 2; ++s2) { const LAS unsigned char* ad = vb0 + (jb * 32 + 16 * s2) * PV; vf[(jb * 2 + s2) * 2] = vtr(ad); vf[(jb * 2 + s2) * 2 + 1] = vtr(ad + 8 * PV); }
            const LAS unsigned char* qa = Qs + (cb * 32 + r32) * PQ + hi * 16; const LAS unsigned char* ka = Ks + r32 * PQ + hi * 16; const LAS unsigned char* sa = STc + (vb * 32 + r32) * PQ + hi * 16;
            bf16x8 fq_[2], fk0[2], fk1[2], fs[2];
            fq_[0] = *(const LAS bf16x8*)qa; fk0[0] = *(const LAS bf16x8*)ka; fk1[0] = *(const LAS bf16x8*)(ka + 32 * PQ); fs[0] = *(const LAS bf16x8*)sa;
#pragma unroll
            for (int s = 0; s < NS; ++s) {
                if (s + 1 < NS) { const int o_ = (s + 1) * 32; fq_[(s + 1) & 1] = *(const LAS bf16x8*)(qa + o_); fk0[(s + 1) & 1] = *(const LAS bf16x8*)(ka + o_); fk1[(s + 1) & 1] = *(const LAS bf16x8*)(ka + 32 * PQ + o_); fs[(s + 1) & 1] = *(const LAS bf16x8*)(sa + o_); }
                __builtin_amdgcn_sched_barrier(0);
                pt0 = __builtin_amdgcn_mfma_f32_32x32x16_bf16(fk0[s & 1], fq_[s & 1], pt0, 0, 0, 0);
                pt1 = __builtin_amdgcn_mfma_f32_32x32x16_bf16(fk1[s & 1], fq_[s & 1], pt1, 0, 0, 0);
                oacc = __builtin_amdgcn_mfma_f32_32x32x16_bf16(fs[s & 1], fq_[s & 1], oacc, 0, 0, 0);
                __builtin_amdgcn_sched_barrier(0);
            }
            const int c = cb * 32 + r32;
#pragma unroll
            for (int r = 0; r < 16; ++r) { const int j0 = crow(r, hi), j1 = 32 + j0;
                const bool k0_ = dir ? (j0 >= c) : (j0 <= c), k1_ = dir ? (j1 >= c) : (j1 <= c);
                pt0[r] = k0_ ? pt0[r] : 0.f; pt1[r] = k1_ ? pt1[r] : 0.f; }
            u32x4 pw[2][2];
#pragma unroll
            for (int s2 = 0; s2 < 2; ++s2) {
                pw[0][s2] = (u32x4){cvtpk(pt0[8 * s2 + 0], pt0[8 * s2 + 1]), cvtpk(pt0[8 * s2 + 2], pt0[8 * s2 + 3]), cvtpk(pt0[8 * s2 + 4], pt0[8 * s2 + 5]), cvtpk(pt0[8 * s2 + 6], pt0[8 * s2 + 7])};
                pw[1][s2] = (u32x4){cvtpk(pt1[8 * s2 + 0], pt1[8 * s2 + 1]), cvtpk(pt1[8 * s2 + 2], pt1[8 * s2 + 3]), cvtpk(pt1[8 * s2 + 4], pt1[8 * s2 + 5]), cvtpk(pt1[8 * s2 + 6], pt1[8 * s2 + 7])};
            }
#pragma unroll
            for (int jb = 0; jb < 2; ++jb)
#pragma unroll
                for (int s2 = 0; s2 < 2; ++s2)
                    oacc = __builtin_amdgcn_mfma_f32_32x32x16_bf16(cat8(vf[(jb * 2 + s2) * 2], vf[(jb * 2 + s2) * 2 + 1]), __builtin_bit_cast(bf16x8, pw[jb][s2]), oacc, 0, 0, 0);
            bf16_t* op = Op + (t0 + c) * (size_t)opitch + vb * 32 + 4 * hi;
#pragma unroll
            for (int g = 0; g < 4; ++g) { u32x2 wv; wv.x = cvtpk(oacc[4 * g], oacc[4 * g + 1]); wv.y = cvtpk(oacc[4 * g + 2], oacc[4 * g + 3]); *(GAS u32x2*)(op + 8 * g) = wv; }
        } else {
            const int sdb = w - 4;
            {
                const int sd = NB == 2 ? sdb : (sdb >> 1), sv0 = NB == 2 ? 0 : (sdb & 1);
                const LAS unsigned char* kb0 = Ks + (8 * hi + qq) * PQ + (sd * 32 + 16 * blk + 4 * pp) * 2;
                s16x4 kf[8];
#pragma unroll
                for (int ks = 0; ks < 4; ++ks) { kf[2 * ks] = vtr(kb0 + 16 * ks * PQ); kf[2 * ks + 1] = vtr(kb0 + (16 * ks + 4) * PQ); }
#pragma unroll
                for (int j = 0; j < NB; ++j) {
                    const int sv = sv0 + j;
                    const LAS unsigned char* va0 = Vs + (8 * hi + qq) * PV + (sv * 32 + 16 * blk + 4 * pp) * 2;
                    s16x4 af[8];
#pragma unroll
                    for (int ks = 0; ks < 4; ++ks) { af[2 * ks] = vtr(va0 + 16 * ks * PV); af[2 * ks + 1] = vtr(va0 + (16 * ks + 4) * PV); }
#pragma unroll
                    for (int ks = 0; ks < 4; ++ks) sacc[j] = __builtin_amdgcn_mfma_f32_32x32x16_bf16(cat8(af[2 * ks], af[2 * ks + 1]), cat8(kf[2 * ks], kf[2 * ks + 1]), sacc[j], 0, 0, 0);
#pragma unroll
                    for (int r = 0; r < 16; ++r) { sacc[j][r] *= dl; *(LAS bf16_t*)(STn + (sv * 32 + crow(r, hi)) * PQ + (sd * 32 + r32) * 2) = f2bf(sacc[j][r]); }
                }
            }
        }
        if (i < 63) { WK_STORE(u_, (u_ + 1) & 1); if (i < 61) WK_LOAD(u_, dir ? n - 3 : n + 3); }
        __syncthreads();
    }
#undef WK_LOAD
#undef WK_STORE
}

template <int NPL>
__device__ __forceinline__ void post_phase(bf16_t* of, const bf16_t* ob, const bf16_t* gt, const float* gain, int gw, int NGW, int lane) {
    float gn[NPL];
#pragma unroll
    for (int i = 0; i < NPL; ++i) gn[i] = gain[(lane & 15) * NPL + i];
    constexpr int R = 4;
    for (int m0 = gw; m0 < T; m0 += R * NGW) {
        u32x4 a[R][NPL / 8], bq[R][NPL / 8], gg[R][NPL / 8];
#pragma unroll
        for (int q = 0; q < R; ++q) { const int m = (m0 + q * NGW) < T ? (m0 + q * NGW) : m0;
#pragma unroll
            for (int c = 0; c < NPL / 8; ++c) { a[q][c] = *(const GA1 u32x4*)(of + (size_t)m * D + lane * NPL + 8 * c); bq[q][c] = *(const GA1 u32x4*)(ob + (size_t)m * PP + lane * NPL + 8 * c); gg[q][c] = *(const GA1 u32x4*)(gt + (size_t)m * PP + lane * NPL + 8 * c); } }
#pragma unroll
        for (int q = 0; q < R; ++q) { const int m = m0 + q * NGW; if (m >= T) break;
            float v[NPL], g[NPL]; float ss = 0.f;
#pragma unroll
            for (int c = 0; c < NPL / 8; ++c)
#pragma unroll
                for (int e = 0; e < 4; ++e) { v[8 * c + 2 * e] = bflo(a[q][c][e]) + bflo(bq[q][c][e]); v[8 * c + 2 * e + 1] = bfhi(a[q][c][e]) + bfhi(bq[q][c][e]); g[8 * c + 2 * e] = bflo(gg[q][c][e]); g[8 * c + 2 * e + 1] = bfhi(gg[q][c][e]); }
#pragma unroll
            for (int i = 0; i < NPL; ++i) ss += v[i] * v[i];
            ss += __shfl_xor(ss, 1); ss += __shfl_xor(ss, 2); ss += __shfl_xor(ss, 4); ss += __shfl_xor(ss, 8);
            const float rs = rsqrtf(ss * (1.f / (16.f * NPL)) + EPS);
            bf16_t* pf = of + (size_t)m * D + lane * NPL;
#pragma unroll
            for (int c = 0; c < NPL / 8; ++c) { u32x4 o;
#pragma unroll
                for (int e = 0; e < 4; ++e) { const int i0 = 8 * c + 2 * e; o[e] = cvtpk(v[i0] * rs * gn[i0] * silu_f(g[i0]), v[i0 + 1] * rs * gn[i0 + 1] * silu_f(g[i0 + 1])); }
                *(GA1 u32x4*)(pf + 8 * c) = o; }
        }
    }
}

#ifdef NO_SW
#define GEMM_SW if (0)
#else
#define GEMM_SW
#endif
#ifdef NO_RES
#define GEMM_RES if (0)
#else
#define GEMM_RES
#endif
#ifdef NO_PROJ
#define GEMM_PROJ if (0)
#else
#define GEMM_PROJ
#endif
constexpr int LDS_BYTES = 147456;
struct Args { const void* in[30]; float* out; unsigned char* ws; };
#define INF(i) ((const float*)args.in[i])

constexpr int NPHASE = 20;
#ifndef DBG_STOP
#define DBG_STOP NPHASE
#endif
__global__ void __launch_bounds__(512, 2) mega_fwd(Args args) {
    extern __shared__ __attribute__((aligned(16))) unsigned char lds_raw[];
    LAS unsigned char* lds = (LAS unsigned char*)lds_raw;
    cg::grid_group grid = cg::this_grid();
    volatile LAS unsigned* MISC = (volatile LAS unsigned*)(lds + 131072 + 320);
    if (threadIdx.x < 64) MISC[threadIdx.x] = 0u;
    __syncthreads();
    grid.sync();
    XcdBarrier bar = xcd_barrier_post((unsigned*)args.ws + 4096, MISC + 8);
    if (threadIdx.x == 0) { const unsigned x_ = xb_xcc_id(); const unsigned r_ = __hip_atomic_fetch_add((unsigned*)args.ws + 64 + x_, 1u, __ATOMIC_RELAXED, __HIP_MEMORY_SCOPE_AGENT); MISC[20] = r_; MISC[21] = x_; MISC[22] = blockIdx.x; }
    __syncthreads();
#pragma unroll 1
    for (int ph = 0; ph < NPHASE; ++ph) {
        if (ph == 1) {
            if (threadIdx.x == 0) { bool ok_ = gridDim.x == 256;
                for (int j = 0; j < 8; ++j) ok_ = ok_ && (__hip_atomic_load((unsigned*)args.ws + 64 + j, __ATOMIC_RELAXED, __HIP_MEMORY_SCOPE_AGENT) == 32u);
                if (ok_) MISC[22] = MISC[20] * 8u + MISC[21]; }
            __syncthreads();
        }
        int tid_ = threadIdx.x; asm volatile("" : "+v"(tid_)); int bid_ = (int)__builtin_amdgcn_readfirstlane((int)MISC[22]); asm volatile("" : "+s"(bid_));
        const int tid = tid_, lane = tid & 63, wave = __builtin_amdgcn_readfirstlane(tid >> 6);
        const int G = gridDim.x, gw = bid_ * 8 + wave, NGW = G * 8;
        unsigned char* ws = args.ws; asm volatile("" : "+s"(ws));
        float* xfin = (float*)(ws + WS_C);
        bf16_t* A = (bf16_t*)(ws + WS_A); bf16_t* B = (bf16_t*)(ws + WS_B);
        bf16_t* XB = (bf16_t*)args.out;
        bf16_t* QGf = (bf16_t*)(ws + WS_C); bf16_t* KGf = (bf16_t*)(ws + WS_C + 32 * MiB); bf16_t* QGb = (bf16_t*)(ws + WS_C + 64 * MiB); bf16_t* KGb = (bf16_t*)(ws + WS_C + 96 * MiB);
        float* LR = (float*)(ws + WS_LR); float* DECf = (float*)(ws + WS_DEC); float* DECb = (float*)(ws + WS_DEC + 1 * MiB);
        float* SSB = (float*)(ws + WS_SS);
        const int layer = ph > 9 ? 1 : 0, step = (ph == 0 || ph == NPHASE - 1) ? -1 : (ph - 1) - 9 * layer;
        if (ph >= DBG_STOP && ph != NPHASE - 1) {
        } else if (ph == 0) {
            {
            LAS float* scr = (LAS float*)(lds + wave * 16384);
            int it = gw;
#pragma unroll 1
            for (int f = 0; f < 4; ++f) {
                const int ly = f >> 1, which = f & 1;
                const float* wg = INF(which ? 7 : 3) + (size_t)ly * D * FF; const float* wu = INF(which ? 8 : 4) + (size_t)ly * D * FF; const float* wd = INF(which ? 9 : 5) + (size_t)ly * FF * D;
                const float* gn = INF(which ? 6 : 2) + ly * D;
                bf16_t* gu = (bf16_t*)(ws + WS_WGU) + (size_t)f * 5632 * 1024; bf16_t* dn = (bf16_t*)(ws + WS_WD) + (size_t)f * 1024 * 2816;
                constexpr int IG = 16 * 88, ID = 44 * 32;
                for (; it < IG; it += NGW) tr_item(wg, D, FF, gu, 1, 1.f, 0, 0, gn, scr, it, lane);
                it -= IG;
                for (; it < IG; it += NGW) tr_item(wu, D, FF, gu, 2, 1.f, 0, 0, gn, scr, it, lane);
                it -= IG;
                for (; it < ID; it += NGW) tr_item(wd, FF, D, dn, 0, 1.f, 0, 0, nullptr, scr, it, lane);
                it -= ID;
            }
            {
                constexpr int I0 = 16 * 96, I1 = 16 * 32, I2 = 16 * 97;
                for (; it < I0; it += NGW) tr_item(INF(11), D, 3072, (bf16_t*)(ws + WS_WIN0), 0, 0.125f * 1.4426950408889634f, 0, 512, INF(10), scr, it, lane);
                it -= I0;
                for (; it < I1; it += NGW) tr_item(INF(20), D, D, (bf16_t*)(ws + WS_WOUT0), 0, 1.f, 0, 0, nullptr, scr, it, lane);
                it -= I1;
                for (; it < I2; it += NGW) tr_item(INF(22), D, 3104, (bf16_t*)(ws + WS_WIN1), 0, 0.08838834764831845f, 0, 512, INF(21), scr, it, lane);
                it -= I2;
                for (; it < I1; it += NGW) tr_item(INF(28), D, D, (bf16_t*)(ws + WS_WOUT1), 0, 1.f, 0, 0, nullptr, scr, it, lane);
            }
            { GA1 u32x4* z = (GA1 u32x4*)((bf16_t*)(ws + WS_WIN1) + (size_t)3104 * 1024); for (int e = bid_ * 512 + tid; e < 224 * 1024 / 8; e += G * 512) z[e] = (u32x4){0u, 0u, 0u, 0u}; }
            }
#ifdef DBL_PRO2
            {
            LAS float* scr = (LAS float*)(lds + wave * 16384);
            int it = gw;
#pragma unroll 1
            for (int f = 0; f < 4; ++f) {
                const int ly = f >> 1, which = f & 1;
                const float* wg = INF(which ? 7 : 3) + (size_t)ly * D * FF; const float* wu = INF(which ? 8 : 4) + (size_t)ly * D * FF; const float* wd = INF(which ? 9 : 5) + (size_t)ly * FF * D;
                const float* gn = INF(which ? 6 : 2) + ly * D;
                bf16_t* gu = (bf16_t*)(ws + WS_WGU) + (size_t)f * 5632 * 1024; bf16_t* dn = (bf16_t*)(ws + WS_WD) + (size_t)f * 1024 * 2816;
                constexpr int IG = 16 * 88, ID = 44 * 32;
                for (; it < IG; it += NGW) tr_item(wg, D, FF, gu, 1, 1.f, 0, 0, gn, scr, it, lane);
                it -= IG;
                for (; it < IG; it += NGW) tr_item(wu, D, FF, gu, 2, 1.f, 0, 0, gn, scr, it, lane);
                it -= IG;
                for (; it < ID; it += NGW) tr_item(wd, FF, D, dn, 0, 1.f, 0, 0, nullptr, scr, it, lane);
                it -= ID;
            }
            {
                constexpr int I0 = 16 * 96, I1 = 16 * 32, I2 = 16 * 97;
                for (; it < I0; it += NGW) tr_item(INF(11), D, 3072, (bf16_t*)(ws + WS_WIN0), 0, 0.125f * 1.4426950408889634f, 0, 512, INF(10), scr, it, lane);
                it -= I0;
                for (; it < I1; it += NGW) tr_item(INF(20), D, D, (bf16_t*)(ws + WS_WOUT0), 0, 1.f, 0, 0, nullptr, scr, it, lane);
                it -= I1;
                for (; it < I2; it += NGW) tr_item(INF(22), D, 3104, (bf16_t*)(ws + WS_WIN1), 0, 0.08838834764831845f, 0, 512, INF(21), scr, it, lane);
                it -= I2;
                for (; it < I1; it += NGW) tr_item(INF(28), D, D, (bf16_t*)(ws + WS_WOUT1), 0, 1.f, 0, 0, nullptr, scr, it, lane);
            }
            { GA1 u32x4* z = (GA1 u32x4*)((bf16_t*)(ws + WS_WIN1) + (size_t)3104 * 1024); for (int e = bid_ * 512 + tid; e < 224 * 1024 / 8; e += G * 512) z[e] = (u32x4){0u, 0u, 0u, 0u}; }
            }
#endif
            cast_phase(INF(0), XB, SSB, gw, NGW, lane);
        } else if (ph == NPHASE - 1) {
            final_phase(A, SSB + (size_t)6 * T * 16, INF(29), args.out, gw, NGW, lane);
        } else if (step == 0 || step == 7) {
            const int f = layer * 2 + (step == 7 ? 1 : 0);
            pg8::Gemm g{XB, (const bf16_t*)(ws + WS_WGU) + (size_t)f * 5632 * 1024, T, 5632, D}; pg8::StaticOrder S; S.init(T, 5632, G, bid_);
            EpiSwiglu E{B, SSB + (size_t)(3 * layer + (step == 7 ? 2 : 0)) * T * 16};
            GEMM_SW pg8::gemm_phase<EpiSwiglu, pg8::StaticOrder, true, true>(lds, g, S, E);
#ifdef DBL_GU
            GEMM_SW pg8::gemm_phase<EpiSwiglu, pg8::StaticOrder, true, true>(lds, g, S, E);
#endif
        } else if (step == 1 || step == 8 || step == 6) {
            const int f = layer * 2 + (step == 8 ? 1 : 0);
            const bf16_t* Am = step == 6 ? A : B;
            const bf16_t* Wm = step == 6 ? (const bf16_t*)(ws + (layer == 0 ? WS_WOUT0 : WS_WOUT1)) : (const bf16_t*)(ws + WS_WD) + (size_t)f * 1024 * 2816;
            pg8::Gemm g{Am, Wm, T, D, step == 6 ? D : FF}; pg8::StaticOrder S; S.init(T, D, G, bid_);
            const bool last = (layer == 1 && step == 8);
            const bf16_t* e_xb = XB; bf16_t* e_out = last ? A : XB; float e_alpha = step == 6 ? 1.0f : 0.5f; float* e_ss = SSB + (size_t)(3 * layer + (step == 1 ? 1 : step == 6 ? 2 : 3)) * T * 16;
            asm volatile("" : "+s"(e_xb), "+s"(e_out), "+s"(e_alpha), "+s"(e_ss));
            EpiRes E{e_xb, e_out, e_alpha, e_ss};
            GEMM_RES pg8::gemm_phase<EpiRes, pg8::StaticOrder, true, true>(lds, g, S, E);
        } else if (step == 2) {
            const int N = layer == 0 ? 3072 : 3328;
            pg8::Gemm g{XB, (const bf16_t*)(ws + (layer == 0 ? WS_WIN0 : WS_WIN1)), T, N, D}; pg8::StaticOrder S; S.init(T, N, G, bid_);
            EpiProj E{B, LR, SSB + (size_t)(3 * layer + 1) * T * 16};
            GEMM_PROJ pg8::gemm_phase<EpiProj, pg8::StaticOrder, true, true>(lds, g, S, E);
#ifdef DBL_PROJ
            GEMM_PROJ pg8::gemm_phase<EpiProj, pg8::StaticOrder, true, true>(lds, g, S, E);
#endif
        } else if (step == 3) {
            if (layer == 0) prep0_phase(B, (const int*)args.in[1], INF(17), INF(18), QGf, KGf, QGb, KGb, DECf, DECb, gw, NGW, lane);
            else { prep1_phase(B, LR, INF(23), INF(24), INF(25), INF(26), QGf, KGf, QGb, KGb, DECf, DECb, tid, lds, bid_, G);
#ifdef DBL_PREP1
                prep1_phase(B, LR, INF(23), INF(24), INF(25), INF(26), QGf, KGf, QGb, KGb, DECf, DECb, tid, lds, bid_, G);
#endif
 }
        } else if (step == 4) {
            if (layer == 0) {
                float s1 = 0.f, s2 = 0.f;
                for (int i = 0; i < 64; ++i) { s1 += INF(12)[i] * INF(13)[i]; s2 += INF(14)[i] * INF(15)[i]; }
                const float lam_init = 0.2f, lam = expf(s1) - expf(s2) + lam_init;
#ifndef SKIP_ATTN
#pragma unroll 1
                for (int u = bid_; u < 1024; u += G) { const int i = u >> 8, bx = u & 255, bh = (bx & 7) * 4 + i, qb = bx >> 3;
                    attn_unit(lds, B, A, bh >> 2, bh & 3, qb, lam, INF(16), 1.f - lam_init);
#ifdef DBL_ATTN
                    attn_unit(lds, B, A, bh >> 2, bh & 3, qb, lam, INF(16), 1.f - lam_init);
#endif
 }
#endif
#ifndef SKIP_WALK
#pragma unroll 1
                for (int u = bid_; u < 128; u += G) { const int x = u & 7, y = u >> 3, vs = y & 1, dir = (y >> 1) & 1, bh = x * 4 + (y >> 2), b = bh >> 2, h = bh & 3;
#define WALK0_CALL                     walk_unit<64>(lds, dir ? QGb : QGf, dir ? KGb : KGf, h, B + 2048 + h * 128 + vs * 64, (dir ? DECb : DECf) + (size_t)bh * 64 * 64, \
                                  dir ? (B + 1536 + h * 128 + vs * 64) : (A + 512 + h * 128 + vs * 64), dir ? PP : D, b, dir);
                    WALK0_CALL
#ifdef DBL_WALK
                    WALK0_CALL
#endif
 }
#endif
            } else {
#ifndef SKIP_WALK
#pragma unroll 1
                for (int u = bid_; u < 256; u += G) { const int x = u & 7, y = u >> 3, vs = y & 3, dir = (y >> 2) & 1, bh = x * 4 + (y >> 3), b = bh >> 2, h = bh & 3;
#define WALK1_CALL                     walk_unit<128>(lds, dir ? QGb : QGf, dir ? KGb : KGf, h, B + 1024 + h * 256 + vs * 64, (dir ? DECb : DECf) + (size_t)bh * 64 * 128, \
                                   dir ? (B + h * 256 + vs * 64) : (A + h * 256 + vs * 64), dir ? PP : D, b, dir);
                    WALK1_CALL
#ifdef DBL_WALK
                    WALK1_CALL
#endif
 }
#endif
            }
        } else if (step == 5) {
            if (layer == 0) post_phase<8>(A + 512, B + 1536, B + 2560, INF(19), gw, NGW, lane);
            else post_phase<16>(A, B, B + 2048, INF(27), gw, NGW, lane);
        }
        if (ph + 1 < NPHASE) xcd_barrier(bar);
#ifdef DBL_BAR
        if (ph + 1 < NPHASE) xcd_barrier(bar);
#endif
    }
}

extern "C" void kernel_launch(void* const* d_in, const int* in_sizes, int n_in, void* d_out, int out_size, void* d_ws, size_t ws_size, hipStream_t stream) {
    static int grid = 0;
    if (grid == 0) {
        if (n_in != 30 || out_size != T * D || ws_size < WS_END) { fprintf(stderr, "kernel_launch: unexpected shapes (n_in %d out %d ws %zu)\n", n_in, out_size, ws_size); grid = -1; return; }
        int dev = 0, cus = 0, per_cu = 0;
        (void)hipGetDevice(&dev); (void)hipDeviceGetAttribute(&cus, hipDeviceAttributeMultiprocessorCount, dev);
        if (hipFuncSetAttribute((const void*)mega_fwd, hipFuncAttributeMaxDynamicSharedMemorySize, LDS_BYTES) != hipSuccess) { fprintf(stderr, "kernel_launch: hipFuncSetAttribute failed\n"); }
        if (hipOccupancyMaxActiveBlocksPerMultiprocessor(&per_cu, (const void*)mega_fwd, 512, LDS_BYTES) != hipSuccess || per_cu < 1) per_cu = 1;
        (void)hipGetLastError();
        grid = cus * per_cu;
        if (grid <= 0) grid = 256;
    }
    if (grid < 0) return;
    Args a{};
    for (int i = 0; i < 30; ++i) a.in[i] = d_in[i];
    a.out = (float*)d_out; a.ws = (unsigned char*)d_ws;
    (void)hipMemsetAsync(d_ws, 0, 65536, stream);
    void* kargs[] = {&a};
    hipError_t e = hipLaunchCooperativeKernel((const void*)mega_fwd, dim3(grid), dim3(512), kargs, LDS_BYTES, stream);
    if (e != hipSuccess) fprintf(stderr, "cooperative launch failed: %s (grid %d)\n", hipGetErrorString(e), grid);
}
```

```cpp
#include <hip/hip_runtime.h>
#include <hip/hip_cooperative_groups.h>
#include <cstdio>
#include <cstdint>
namespace cg = cooperative_groups;
namespace pg8 {
#define PG8_LAS __attribute__((address_space(3)))
typedef unsigned short bf16_t;
typedef short bf16x8 __attribute__((ext_vector_type(8)));
typedef float f32x4 __attribute__((ext_vector_type(4)));
typedef unsigned u32x4 __attribute__((ext_vector_type(4)));
constexpr int BM = 256, BK = 64, HALF = 128, HTB = HALF * BK * 2  , STAGE_BYTES = 8 * HTB, NXCD = 8, WGM = 8;

__host__ __device__ __forceinline__ int lds_byte(int r, int c) { const int st = (r >> 4) * 2 + (c >> 5), rr = r & 15, cc = c & 31, ob = rr * 64 + cc * 2; return st * 1024 + (ob ^ (((ob >> 9) & 1) << 5)); }
__host__ __device__ __forceinline__ void stage_rc(int b, int& R, int& C) { const int st = b / 1024, sb = b % 1024, swz = sb ^ (((sb >> 9) & 1) << 5); R = (st >> 1) * 16 + swz / 64; C = (st & 1) * 32 + (swz % 64) / 2; }
__host__ __device__ __forceinline__ int perm32(int rho) { const int n = rho >> 4, i = rho & 15; return 8 * (i >> 2) + 4 * n + (i & 3); }

struct Unit { int pm, pn; };
struct Gemm { const bf16_t* A; const bf16_t* Bt; int M, N, K; };

struct StaticOrder {
    int nM, nN, nwg, G, c;
    __host__ __device__ void init(int M, int N, int G_, int c_) { nM = M / BM; nN = N / BM; nwg = nM * nN; G = G_; c = c_; }
    __host__ __device__ bool next(int i, Unit& u) const {
        const long L = (long)i * G + c; if (L >= nwg) return false;
        int wgid = (int)L; { const int q = nwg / NXCD, r = nwg % NXCD, xcd = wgid % NXCD, off = wgid / NXCD; wgid = (xcd < r ? xcd * (q + 1) : r * (q + 1) + (xcd - r) * q) + off; }
        const int nig = WGM * nN, gid = wgid / nig, fm = gid * WGM, gsz = (nM - fm) < WGM ? (nM - fm) : WGM;
        u.pm = fm + ((wgid % nig) % gsz); u.pn = (wgid % nig) / gsz; return true;
    }
    __device__ __forceinline__ void a_ready(const Unit&) const {}
    __device__ __forceinline__ void done(const Unit&) const {}
};
__device__ __forceinline__ unsigned cvt_pk_bf16(float lo, float hi) { unsigned r; asm volatile("v_cvt_pk_bf16_f32 %0, %1, %2" : "=v"(r) : "v"(lo), "v"(hi)); return r; }
typedef float f32x2 __attribute__((ext_vector_type(2)));
template <class Epi, class Sched, bool ALIGN_EPI = false, bool SP2 = false>
__device__ __forceinline__ void gemm_phase(PG8_LAS unsigned char* lds, const Gemm g, const Sched& S, const Epi& E) {
    int tid_ = threadIdx.x; asm volatile("" : "+v"(tid_)); const int tid = tid_, wid = __builtin_amdgcn_readfirstlane(tid >> 6), lane = tid & 63, wr = wid >> 2, wc = wid & 3, fr = lane & 15, fq = lane >> 4;
    const int K = g.K, nt = K / BK;
    unsigned voffA[2], voffB[2];
#pragma unroll
    for (int i = 0; i < 2; ++i) { int R, C; stage_rc(tid * 16 + i * 8192, R, C); const int Rb = Epi::PERM ? ((R & ~31) + perm32(R & 31)) : R;
        voffA[i] = (unsigned)(R * K + C) * 2u; voffB[i] = (unsigned)(Rb * K + C) * 2u; }
    const size_t kstep = (size_t)(BK * 2);
    const size_t hstep = (size_t)HALF * K * 2;
    const size_t tstep = 2 * hstep;
    const unsigned ldsw = (unsigned)wid * 1024u;
    const int aoff = lds_byte(wr * 64 + fr, fq * 8), boff = lds_byte(wc * 32 + fr, fq * 8);
#define PG8_SA(b, h) (((b) * 2 + (h)) * HTB)
#define PG8_SB(b, h) ((4 + (b) * 2 + (h)) * HTB)
#define PG8_STAGE(bufoff, gbase, voff) do { _Pragma("unroll") for (int _i = 0; _i < 2; ++_i) \
        __builtin_amdgcn_global_load_lds((const unsigned*)((const char*)(gbase) + (voff)[_i]), (PG8_LAS unsigned*)(lds + (bufoff) + ldsw + _i * 8192), 16, 0, 0); } while (0)
#define PG8_LDA(dst, b, h) do { _Pragma("unroll") for (int m = 0; m < 4; ++m) _Pragma("unroll") for (int k = 0; k < 2; ++k) dst[m][k] = *(const PG8_LAS bf16x8*)(lds + PG8_SA(b, h) + aoff + m * 2048 + k * 1024); } while (0)
#define PG8_LDB(dst, b, h) do { _Pragma("unroll") for (int n = 0; n < 2; ++n) _Pragma("unroll") for (int k = 0; k < 2; ++k) dst[n][k] = *(const PG8_LAS bf16x8*)(lds + PG8_SB(b, h) + boff + n * 2048 + k * 1024); } while (0)
#define PG8_MMA(ai, bj, At, Bt) do { __builtin_amdgcn_s_setprio(1); _Pragma("unroll") for (int m = 0; m < 4; ++m) _Pragma("unroll") for (int n = 0; n < 2; ++n) _Pragma("unroll") for (int k = 0; k < 2; ++k) \
        acc[ai][bj][m][n] = __builtin_amdgcn_mfma_f32_16x16x32_bf16(Bt[n][k], At[m][k], acc[ai][bj][m][n], 0, 0, 0); __builtin_amdgcn_s_setprio(0); } while (0)
#define PG8_WAIT_V(n) asm volatile("s_waitcnt vmcnt(" #n ")" ::: "memory")
#define PG8_WAIT_L(n) asm volatile("s_waitcnt lgkmcnt(" #n ")" ::: "memory")
#define PG8_BAR __builtin_amdgcn_s_barrier()
#define PG8_SCHED __builtin_amdgcn_sched_barrier(0)
    Unit cur, nxt; int ui = 0;
    if (!S.next(0, cur)) return;
    f32x4 acc[2][2][4][2];
#pragma unroll
    for (int a = 0; a < 2; ++a)
#pragma unroll
        for (int b = 0; b < 2; ++b)
#pragma unroll
            for (int m = 0; m < 4; ++m)
#pragma unroll
                for (int n = 0; n < 2; ++n) acc[a][b][m][n] = (f32x4){0.f, 0.f, 0.f, 0.f};
    bf16x8 At[4][2], B0[2][2], B1[2][2];
    const char* cA = (const char*)g.A + (size_t)cur.pm * tstep; const char* cB = (const char*)g.Bt + (size_t)cur.pn * tstep;
    S.a_ready(cur);
    if constexpr (SP2) {
        PG8_STAGE(PG8_SB(0, 0), cB, voffB); PG8_STAGE(PG8_SB(0, 1), cB + hstep, voffB); PG8_STAGE(PG8_SA(0, 0), cA, voffA); PG8_STAGE(PG8_SA(0, 1), cA + hstep, voffA);
        if (wr == 1) PG8_BAR;
        PG8_WAIT_V(2); PG8_BAR;
        PG8_STAGE(PG8_SB(1, 0), cB + kstep, voffB); PG8_STAGE(PG8_SA(1, 0), cA + kstep, voffA); PG8_STAGE(PG8_SB(1, 1), cB + hstep + kstep, voffB);
        PG8_WAIT_V(6); PG8_BAR;
    } else {
        PG8_STAGE(PG8_SB(0, 0), cB, voffB); PG8_STAGE(PG8_SA(0, 0), cA, voffA); PG8_STAGE(PG8_SB(0, 1), cB + hstep, voffB); PG8_STAGE(PG8_SA(0, 1), cA + hstep, voffA);
        if (wr == 1) PG8_BAR;
        PG8_WAIT_V(4); PG8_BAR;
        PG8_STAGE(PG8_SB(1, 0), cB + kstep, voffB); PG8_STAGE(PG8_SA(1, 0), cA + kstep, voffA); PG8_STAGE(PG8_SB(1, 1), cB + hstep + kstep, voffB);
        PG8_WAIT_V(6); PG8_BAR;
    }
    for (;;) {
        const bool has_next = S.next(ui + 1, nxt);
        const char* nA = has_next ? (const char*)g.A + (size_t)nxt.pm * tstep : cA; const char* nB = has_next ? (const char*)g.Bt + (size_t)nxt.pn * tstep : cB;
        for (int t = 0; t < nt; t += 2) {
            const bool last = (t == nt - 2);
            const char* a1 = cA + (size_t)(t + 1) * kstep;
            const char* a2 = last ? nA : cA + (size_t)(t + 2) * kstep; const char* b2 = last ? nB : cB + (size_t)(t + 2) * kstep;
            const char* a3 = a2 + kstep; const char* b3 = b2 + kstep;
            if (last && has_next) S.a_ready(nxt);
            if constexpr (SP2) {
            PG8_LDB(B0, 0, 0); PG8_LDB(B1, 0, 1); PG8_SCHED; PG8_LDA(At, 0, 0); PG8_STAGE(PG8_SA(1, 1), a1 + hstep, voffA);
            PG8_WAIT_V(8); PG8_WAIT_L(0); PG8_BAR; PG8_MMA(0, 0, At, B0); PG8_MMA(0, 1, At, B1); PG8_BAR; PG8_SCHED;
            PG8_LDA(At, 0, 1); PG8_STAGE(PG8_SB(0, 0), b2, voffB); PG8_STAGE(PG8_SB(0, 1), b2 + hstep, voffB); PG8_STAGE(PG8_SA(0, 0), a2, voffA);
            PG8_WAIT_V(8); PG8_WAIT_L(0); PG8_BAR; PG8_MMA(1, 0, At, B0); PG8_MMA(1, 1, At, B1); PG8_BAR; PG8_SCHED;
            PG8_LDB(B0, 1, 0); PG8_LDB(B1, 1, 1); PG8_SCHED; PG8_LDA(At, 1, 0); PG8_STAGE(PG8_SA(0, 1), a2 + hstep, voffA);
            PG8_WAIT_V(8); PG8_WAIT_L(0); PG8_BAR; PG8_MMA(0, 0, At, B0); PG8_MMA(0, 1, At, B1); PG8_BAR; PG8_SCHED;
            PG8_LDA(At, 1, 1); PG8_STAGE(PG8_SB(1, 0), b3, voffB); PG8_STAGE(PG8_SB(1, 1), b3 + hstep, voffB); PG8_STAGE(PG8_SA(1, 0), a3, voffA);
            PG8_WAIT_V(8); PG8_WAIT_L(0); PG8_BAR; PG8_MMA(1, 0, At, B0); PG8_MMA(1, 1, At, B1); PG8_BAR; PG8_SCHED;
            } else {
            PG8_LDB(B0, 0, 0); PG8_SCHED; PG8_LDA(At, 0, 0); PG8_STAGE(PG8_SA(1, 1), a1 + hstep, voffA);
            PG8_WAIT_L(8); PG8_BAR; PG8_WAIT_L(0); PG8_MMA(0, 0, At, B0); PG8_BAR; PG8_SCHED;
            PG8_LDB(B1, 0, 1); PG8_STAGE(PG8_SB(0, 0), b2, voffB);
            PG8_BAR; PG8_WAIT_L(0); PG8_MMA(0, 1, At, B1); PG8_BAR;
            PG8_LDA(At, 0, 1); PG8_STAGE(PG8_SA(0, 0), a2, voffA);
            PG8_BAR; PG8_WAIT_L(0); PG8_MMA(1, 0, At, B0); PG8_BAR; PG8_SCHED;
            PG8_STAGE(PG8_SB(0, 1), b2 + hstep, voffB);
            PG8_WAIT_V(6); PG8_BAR; PG8_MMA(1, 1, At, B1); PG8_BAR;
            PG8_LDB(B0, 1, 0); PG8_SCHED; PG8_LDA(At, 1, 0); PG8_STAGE(PG8_SA(0, 1), a2 + hstep, voffA);
            PG8_WAIT_L(8); PG8_BAR; PG8_WAIT_L(0); PG8_MMA(0, 0, At, B0); PG8_BAR; PG8_SCHED;
            PG8_LDB(B1, 1, 1); PG8_STAGE(PG8_SB(1, 0), b3, voffB);
            PG8_BAR; PG8_WAIT_L(0); PG8_MMA(0, 1, At, B1); PG8_BAR;
            PG8_LDA(At, 1, 1); PG8_STAGE(PG8_SA(1, 0), a3, voffA);
            PG8_BAR; PG8_WAIT_L(0); PG8_MMA(1, 0, At, B0); PG8_BAR; PG8_SCHED;
            PG8_STAGE(PG8_SB(1, 1), b3 + hstep, voffB);
            PG8_WAIT_V(6); PG8_BAR; PG8_MMA(1, 1, At, B1); PG8_BAR;
            }
        }
        if constexpr (ALIGN_EPI) { if (wr == 0) PG8_BAR; }
        if constexpr (!Epi::AFTER_DRAIN) { E(acc, cur, wr, wc, fr, fq); S.done(cur); }
        if (!has_next) break;
#pragma unroll
        for (int a = 0; a < 2; ++a)
#pragma unroll
            for (int b = 0; b < 2; ++b)
#pragma unroll
                for (int m = 0; m < 4; ++m)
#pragma unroll
                    for (int n = 0; n < 2; ++n) acc[a][b][m][n] = (f32x4){0.f, 0.f, 0.f, 0.f};
        cur = nxt; cA = nA; cB = nB; ++ui;
        if constexpr (ALIGN_EPI) { if (wr == 1) PG8_BAR; }
    }
    PG8_WAIT_V(0);
    if constexpr (!ALIGN_EPI) { if (wr == 0) PG8_BAR; }
    PG8_BAR;
    if constexpr (Epi::AFTER_DRAIN) { E.fused(acc, cur, wr, wc, fr, fq, lds, wid, lane); S.done(cur); }
#undef PG8_SA
#undef PG8_SB
#undef PG8_STAGE
#undef PG8_LDA
#undef PG8_LDB
#undef PG8_MMA
#undef PG8_WAIT_V
#undef PG8_WAIT_L
#undef PG8_BAR
#undef PG8_SCHED
}
}
#define LAS __attribute__((address_space(3)))
#define GA1 __attribute__((address_space(1)))
typedef unsigned short bf16_t;
typedef short bf16x8 __attribute__((ext_vector_type(8)));
typedef short s16x4 __attribute__((ext_vector_type(4)));
typedef short v4i16_t __attribute__((ext_vector_type(4)));
typedef float f32x4 __attribute__((ext_vector_type(4)));
typedef float f32x16 __attribute__((ext_vector_type(16)));
typedef unsigned u32x4 __attribute__((ext_vector_type(4)));
typedef unsigned u32x2 __attribute__((ext_vector_type(2)));

constexpr int T = 32768, D = 1024, FF = 2816, SEQ = 4096, PP = 3072;
constexpr float EPS = 1e-6f;
constexpr size_t MiB = 1u << 20;
constexpr size_t WS_WGU = 1 * MiB;
constexpr size_t WS_WD = WS_WGU + 44 * MiB;
constexpr size_t WS_WIN0 = WS_WD + 22 * MiB;
constexpr size_t WS_WOUT0 = WS_WIN0 + 6 * MiB;
constexpr size_t WS_WIN1 = WS_WOUT0 + 2 * MiB;
constexpr size_t WS_WOUT1 = WS_WIN1 + 7 * MiB;
constexpr size_t WS_A = 84 * MiB;
constexpr size_t WS_B = 148 * MiB;
constexpr size_t WS_C = 340 * MiB;
constexpr size_t WS_LR = 468 * MiB;
constexpr size_t WS_DEC = 472 * MiB;
constexpr size_t WS_SS = 476 * MiB;
constexpr size_t WS_END = 490 * MiB;
static_assert(WS_WOUT1 + 2 * MiB <= WS_A, "ws map");

typedef float f32x2_t __attribute__((ext_vector_type(2))); typedef __bf16 bf16x2_t __attribute__((ext_vector_type(2)));
__device__ __forceinline__ unsigned cvtpk(float lo, float hi) { f32x2_t v = {lo, hi}; bf16x2_t b = __builtin_convertvector(v, bf16x2_t); return __builtin_bit_cast(unsigned, b); }
__device__ __forceinline__ float bf2f(bf16_t b) { return __uint_as_float((unsigned)b << 16); }
__device__ __forceinline__ float bflo(unsigned w) { return __uint_as_float(w << 16); }
__device__ __forceinline__ float bfhi(unsigned w) { return __uint_as_float(w & 0xffff0000u); }
__device__ __forceinline__ bf16_t f2bf(float f) { return (bf16_t)(cvtpk(f, 0.f) & 0xffffu); }
__device__ __forceinline__ int crow(int r, int hi) { return (r & 3) + 8 * (r >> 2) + 4 * hi; }
__device__ __forceinline__ s16x4 vtr(const LAS unsigned char* p) { return __builtin_bit_cast(s16x4, __builtin_amdgcn_ds_read_tr16_b64_v4i16((LAS v4i16_t*)p)); }
__device__ __forceinline__ bf16x8 cat8(s16x4 a, s16x4 b) { return (bf16x8){a[0], a[1], a[2], a[3], b[0], b[1], b[2], b[3]}; }
__device__ __forceinline__ float wave_sum(float v) {
#pragma unroll
    for (int o = 1; o < 64; o <<= 1) v += __shfl_xor(v, o);
    return v;
}
__device__ __forceinline__ float silu_f(float g) { return g * __builtin_amdgcn_rcpf(1.f + __expf(-g)); }
__device__ __forceinline__ void sincos_rev(float ang, float& sn, float& cs) {
    const double rev = (double)ang * 0.15915494309189535; const float fr = (float)(rev - floor(rev));
    sn = __builtin_amdgcn_sinf(fr); cs = __builtin_amdgcn_cosf(fr);
}
__device__ __forceinline__ float logsig(float z) { return fminf(z, 0.f) - log1pf(expf(-fabsf(z))); }

__device__ __forceinline__ void rows_rs(const float* SS, int row0, int fq, float (&rsv)[2][4]) {
    f32x4 p[2][4];
#pragma unroll
    for (int ai = 0; ai < 2; ++ai)
#pragma unroll
        for (int m = 0; m < 4; ++m) p[ai][m] = *(const GA1 f32x4*)(SS + (size_t)(row0 + ai * 128 + m * 16) * 16 + fq * 4);
#pragma unroll
    for (int ai = 0; ai < 2; ++ai)
#pragma unroll
        for (int m = 0; m < 4; ++m) { float s = (p[ai][m][0] + p[ai][m][1]) + (p[ai][m][2] + p[ai][m][3]); s += __shfl_xor(s, 16); s += __shfl_xor(s, 32); rsv[ai][m] = rsqrtf(s * (1.f / D) + EPS); }
}
struct EpiSwiglu {
    static constexpr bool PERM = true, AFTER_DRAIN = false;
    bf16_t* O; const float* SS;
    __device__ __forceinline__ void operator()(const f32x4 (&acc)[2][2][4][2], const pg8::Unit& u, int wr, int wc, int fr, int fq) const {
        const int row0 = u.pm * 256 + wr * 64 + fr, f0 = u.pn * 128 + wc * 32 + 8 * fq;
        float rsv[2][4]; rows_rs(SS, row0, fq, rsv);
#pragma unroll
        for (int ai = 0; ai < 2; ++ai)
#pragma unroll
            for (int m = 0; m < 4; ++m) {
                const int row = row0 + ai * 128 + m * 16;
                const float rs = rsv[ai][m];
                bf16_t* p = O + (size_t)row * FF + f0;
                const f32x4 g0 = acc[ai][0][m][0] * rs, g1 = acc[ai][0][m][1] * rs, u0 = acc[ai][1][m][0] * rs, u1 = acc[ai][1][m][1] * rs;
                u32x4 w;
                w.x = cvtpk(silu_f(g0[0]) * u0[0], silu_f(g0[1]) * u0[1]); w.y = cvtpk(silu_f(g0[2]) * u0[2], silu_f(g0[3]) * u0[3]);
                w.z = cvtpk(silu_f(g1[0]) * u1[0], silu_f(g1[1]) * u1[1]); w.w = cvtpk(silu_f(g1[2]) * u1[2], silu_f(g1[3]) * u1[3]);
                *(GA1 u32x4*)p = w;
            }
    }
};
struct EpiRes {
    static constexpr bool PERM = true, AFTER_DRAIN = false;
    const bf16_t* XB; bf16_t* XW; float alpha; float* SSo;
    __device__ __forceinline__ void operator()(const f32x4 (&acc)[2][2][4][2], const pg8::Unit& u, int wr, int wc, int fr, int fq) const {
        const int row0 = u.pm * 256 + wr * 64 + fr, col0 = u.pn * 256 + wc * 32 + 8 * fq;
        const bf16_t* XB = this->XB; bf16_t* XW = this->XW; float alpha = this->alpha; float* SSo = this->SSo;
        asm volatile("" : "+s"(XB), "+s"(XW), "+s"(alpha), "+s"(SSo));
#pragma unroll
        for (int ai = 0; ai < 2; ++ai) {
            u32x4 bs[4][2];
#pragma unroll
            for (int m = 0; m < 4; ++m)
#pragma unroll
                for (int bj = 0; bj < 2; ++bj) bs[m][bj] = *(const GA1 u32x4*)(XB + (size_t)(row0 + ai * 128 + m * 16) * D + col0 + bj * 128);
#pragma unroll
            for (int m = 0; m < 4; ++m) {
                const int row = row0 + ai * 128 + m * 16;
                const size_t off = (size_t)row * D + col0;
                float ss = 0.f;
#pragma unroll
                for (int bj = 0; bj < 2; ++bj) { const size_t o = off + bj * 128; const u32x4 b = bs[m][bj];
                    const f32x4 v0 = (f32x4){bflo(b.x), bfhi(b.x), bflo(b.y), bfhi(b.y)} + alpha * acc[ai][bj][m][0], v1 = (f32x4){bflo(b.z), bfhi(b.z), bflo(b.w), bfhi(b.w)} + alpha * acc[ai][bj][m][1];
                    u32x4 w; w.x = cvtpk(v0[0], v0[1]); w.y = cvtpk(v0[2], v0[3]); w.z = cvtpk(v1[0], v1[1]); w.w = cvtpk(v1[2], v1[3]); *(GA1 u32x4*)(XW + o) = w;
                    ss += ((v0[0] * v0[0] + v0[1] * v0[1]) + (v0[2] * v0[2] + v0[3] * v0[3])) + ((v1[0] * v1[0] + v1[1] * v1[1]) + (v1[2] * v1[2] + v1[3] * v1[3])); }
                ss += __shfl_xor(ss, 16); ss += __shfl_xor(ss, 32); if (fq == 0) *(GA1 float*)(SSo + (size_t)row * 16 + u.pn * 4 + wc) = ss;
            }
        }
    }
};
struct EpiProj {
    static constexpr bool PERM = true, AFTER_DRAIN = false;
    bf16_t* O; float* LR; const float* SS;
    __device__ __forceinline__ void operator()(const f32x4 (&acc)[2][2][4][2], const pg8::Unit& u, int wr, int wc, int fr, int fq) const {
        const int row0 = u.pm * 256 + wr * 64 + fr;
        float rsv[2][4]; rows_rs(SS, row0, fq, rsv);
        if (u.pn >= 12) {
            if (wc == 0) {
#pragma unroll
                for (int ai = 0; ai < 2; ++ai)
#pragma unroll
                    for (int m = 0; m < 4; ++m) { const int row = row0 + ai * 128 + m * 16; const float rs = rsv[ai][m];
                        float* p = LR + (size_t)row * 32 + 8 * fq; *(GA1 f32x4*)p = acc[ai][0][m][0] * rs; *(GA1 f32x4*)(p + 4) = acc[ai][0][m][1] * rs; }
            }
            return;
        }
        const int col0 = u.pn * 256 + wc * 32 + 8 * fq;
#pragma unroll
        for (int ai = 0; ai < 2; ++ai)
#pragma unroll
            for (int m = 0; m < 4; ++m) {
                const int row = row0 + ai * 128 + m * 16; const float rs = rsv[ai][m];
                bf16_t* p = O + (size_t)row * PP + col0;
#pragma unroll
                for (int bj = 0; bj < 2; ++bj) { const f32x4 v0 = acc[ai][bj][m][0] * rs, v1 = acc[ai][bj][m][1] * rs; u32x4 w; w.x = cvtpk(v0[0], v0[1]); w.y = cvtpk(v0[2], v0[3]); w.z = cvtpk(v1[0], v1[1]); w.w = cvtpk(v1[2], v1[3]); *(GA1 u32x4*)(p + bj * 128) = w; }
            }
    }
};

__device__ __forceinline__ void tr_item(const float* W, int K, int N, bf16_t* WT, int mode, float sc, int sc_lo, int sc_hi, const float* gain, LAS float* scr, int item, int lane) {
    const int nblk = N / 32, kb = item / nblk, nb = item % nblk, k0 = 64 * kb, n0 = 32 * nb;
#pragma unroll 8
    for (int i = 0; i < 32; ++i) { const int kk = 2 * i + (lane >> 5); scr[kk * 33 + (lane & 31)] = W[(size_t)(k0 + kk) * N + n0 + (lane & 31)]; }
    asm volatile("s_waitcnt lgkmcnt(0)" ::: "memory");
    const int d0 = mode ? (256 * (n0 >> 7) + (n0 & 127) + (mode == 2 ? 128 : 0)) : n0;
    const float s = (n0 >= sc_lo && n0 < sc_hi) ? sc : 1.f;
    const int c = lane & 7;
    f32x4 ga = {s, s, s, s}, gb = {s, s, s, s};
    if (gain) { ga = ga * *(const GA1 f32x4*)(gain + k0 + 8 * c); gb = gb * *(const GA1 f32x4*)(gain + k0 + 8 * c + 4); }
#pragma unroll
    for (int j = 0; j < 4; ++j) { const int n = (lane >> 3) + 8 * j; const LAS float* p = scr + (8 * c) * 33 + n;
        u32x4 o; o.x = cvtpk(p[0 * 33] * ga[0], p[1 * 33] * ga[1]); o.y = cvtpk(p[2 * 33] * ga[2], p[3 * 33] * ga[3]); o.z = cvtpk(p[4 * 33] * gb[0], p[5 * 33] * gb[1]); o.w = cvtpk(p[6 * 33] * gb[2], p[7 * 33] * gb[3]);
        *(GA1 u32x4*)(WT + (size_t)(d0 + n) * K + k0 + 8 * c) = o; }
    asm volatile("s_waitcnt lgkmcnt(0)" ::: "memory");
}

template <bool OUT_F32>
__device__ __forceinline__ void norm_phase(const float* src, const float* gain, bf16_t* dst, float* dstf, int gw, int NGW, int lane) {
    f32x4 g[4];
#pragma unroll
    for (int j = 0; j < 4; ++j) g[j] = ((const f32x4*)gain)[lane + 64 * j];
    for (int m0 = gw; m0 < T; m0 += 4 * NGW) {
        f32x4 v[4][4]; float ss[4];
#pragma unroll
        for (int q = 0; q < 4; ++q) { const int m = m0 + q * NGW; const GA1 f32x4* xr = (const GA1 f32x4*)(src + (size_t)(m < T ? m : m0) * D) + lane;
#pragma unroll
            for (int j = 0; j < 4; ++j) v[q][j] = xr[64 * j]; }
#pragma unroll
        for (int q = 0; q < 4; ++q) { float a = 0.f;
#pragma unroll
            for (int j = 0; j < 4; ++j) a += (v[q][j].x * v[q][j].x + v[q][j].y * v[q][j].y) + (v[q][j].z * v[q][j].z + v[q][j].w * v[q][j].w);
            ss[q] = a; }
#pragma unroll
        for (int o = 1; o < 64; o <<= 1)
#pragma unroll
            for (int q = 0; q < 4; ++q) ss[q] += __shfl_xor(ss[q], o);
#pragma unroll
        for (int q = 0; q < 4; ++q) { const int m = m0 + q * NGW; if (m >= T) break;
            const float r = rsqrtf(ss[q] * (1.f / D) + EPS);
            if (OUT_F32) { GA1 f32x4* o = (GA1 f32x4*)(dstf + (size_t)m * D) + lane;
#pragma unroll
                for (int j = 0; j < 4; ++j) o[64 * j] = v[q][j] * r * g[j];
            } else { GA1 u32x2* o = (GA1 u32x2*)(dst + (size_t)m * D) + lane;
#pragma unroll
                for (int j = 0; j < 4; ++j) { const f32x4 y = v[q][j] * r * g[j]; u32x2 w; w.x = cvtpk(y.x, y.y); w.y = cvtpk(y.z, y.w); o[64 * j] = w; } }
        }
    }
}

__device__ __forceinline__ void final_phase(const bf16_t* src, const float* SS, const float* gain, float* dstf, int gw, int NGW, int lane) {
    f32x4 g[4];
#pragma unroll
    for (int j = 0; j < 4; ++j) g[j] = ((const f32x4*)gain)[lane * 4 + j];
    for (int m0 = gw; m0 < T; m0 += 4 * NGW) {
        u32x4 v[4][2]; float pr[4];
#pragma unroll
        for (int q = 0; q < 4; ++q) { const int m = (m0 + q * NGW) < T ? (m0 + q * NGW) : m0; const GA1 u32x4* xr = (const GA1 u32x4*)(src + (size_t)m * D + lane * 16); v[q][0] = xr[0]; v[q][1] = xr[1];
            pr[q] = SS[(size_t)m * 16 + (lane & 15)]; }
#pragma unroll
        for (int q = 0; q < 4; ++q) { float a = pr[q]; a += __shfl_xor(a, 1); a += __shfl_xor(a, 2); a += __shfl_xor(a, 4); a += __shfl_xor(a, 8); pr[q] = rsqrtf(a * (1.f / D) + EPS); }
#pragma unroll
        for (int q = 0; q < 4; ++q) { const int m = m0 + q * NGW; if (m >= T) break;
            GA1 f32x4* o = (GA1 f32x4*)(dstf + (size_t)m * D + lane * 16); const float r = pr[q];
#pragma unroll
            for (int c = 0; c < 2; ++c) { const u32x4 b = v[q][c];
                o[2 * c] = (f32x4){bflo(b.x), bfhi(b.x), bflo(b.y), bfhi(b.y)} * r * g[2 * c]; o[2 * c + 1] = (f32x4){bflo(b.z), bfhi(b.z), bflo(b.w), bfhi(b.w)} * r * g[2 * c + 1]; }
        }
    }
}

__device__ __forceinline__ void cast_phase(const float* src, bf16_t* dst, float* SSo, int gw, int NGW, int lane) {
    for (int m0 = gw; m0 < T; m0 += 4 * NGW) {
        f32x4 v[4][4]; float ss[4];
#pragma unroll
        for (int q = 0; q < 4; ++q) { const int m = m0 + q * NGW; const GA1 f32x4* xr = (const GA1 f32x4*)(src + (size_t)(m < T ? m : m0) * D) + lane;
#pragma unroll
            for (int j = 0; j < 4; ++j) v[q][j] = xr[64 * j]; }
#pragma unroll
        for (int q = 0; q < 4; ++q) { float a = 0.f;
#pragma unroll
            for (int j = 0; j < 4; ++j) a += (v[q][j].x * v[q][j].x + v[q][j].y * v[q][j].y) + (v[q][j].z * v[q][j].z + v[q][j].w * v[q][j].w);
            ss[q] = a; }
#pragma unroll
        for (int o = 1; o < 64; o <<= 1)
#pragma unroll
            for (int q = 0; q < 4; ++q) ss[q] += __shfl_xor(ss[q], o);
#pragma unroll
        for (int q = 0; q < 4; ++q) { const int m = m0 + q * NGW; if (m >= T) break;
            GA1 u32x2* o = (GA1 u32x2*)(dst + (size_t)m * D) + lane;
#pragma unroll
            for (int j = 0; j < 4; ++j) { u32x2 w; w.x = cvtpk(v[q][j].x, v[q][j].y); w.y = cvtpk(v[q][j].z, v[q][j].w); o[64 * j] = w; }
            if (lane < 16) SSo[(size_t)m * 16 + lane] = lane == 0 ? ss[q] : 0.f; }
    }
}

__device__ __forceinline__ void prep0_phase(bf16_t* P, const int* pos, const float* logit_f, const float* logit_b, bf16_t* QGf, bf16_t* KGf, bf16_t* QGb, bf16_t* KGb,
                                            float* DECf, float* DECb, int gw, int NGW, int lane) {
    const int fa = lane & 7, fr_ = lane & 31, hh = lane >> 5;
    const float inva = exp2f(-18.931568569324174f * (float)(2 * fa) * (1.f / 16.f));
    const float invr = exp2f(-13.287712379549449f * (float)(2 * fr_) * (1.f / 64.f));
    float lgf[4], lgb[4];
#pragma unroll
    for (int h = 0; h < 4; ++h) { lgf[h] = logsig(logit_f[h]); lgb[h] = logsig(logit_b[h]); }
    for (int m = gw; m < T; m += NGW) {
        const int b = m >> 12, s = m & 4095, c = s & 63;
        const float posf = (float)pos[s];
        bf16_t* row = P + (size_t)m * PP;
        unsigned short ar[2][2], rr[4][2];
#pragma unroll
        for (int i = 0; i < 2; ++i) { const int col = i * 512 + (lane >> 3) * 64 + fa; ar[i][0] = *(const GA1 bf16_t*)(row + col); ar[i][1] = *(const GA1 bf16_t*)(row + col + 8); }
#pragma unroll
        for (int i = 0; i < 4; ++i) { const int which = i >> 1, head = ((i & 1) << 1) | hh, col = 1536 + which * 256 + head * 64 + fr_; rr[i][0] = *(const GA1 bf16_t*)(row + col); rr[i][1] = *(const GA1 bf16_t*)(row + col + 32); }
        {
            float sn, cs; sincos_rev(posf * inva, sn, cs);
#pragma unroll
            for (int i = 0; i < 2; ++i) { const int col = i * 512 + (lane >> 3) * 64 + fa; const float x1 = bf2f(ar[i][0]), x2 = bf2f(ar[i][1]);
                *(GA1 bf16_t*)(row + col) = f2bf(x1 * cs - x2 * sn); *(GA1 bf16_t*)(row + col + 8) = f2bf(x1 * sn + x2 * cs); }
        }
        {
            float sn, cs; sincos_rev(posf * invr, sn, cs);
#pragma unroll
            for (int i = 0; i < 4; ++i) {
                const int which = i >> 1, head = ((i & 1) << 1) | hh;
                const float lf = hh ? lgf[((i & 1) << 1) | 1] : lgf[(i & 1) << 1], lb = hh ? lgb[((i & 1) << 1) | 1] : lgb[(i & 1) << 1];
                const float x1 = bf2f(rr[i][0]), x2 = bf2f(rr[i][1]);
                const float ksc = which ? 0.125f : 1.f;
                const float y1 = (x1 * cs - x2 * sn) * ksc, y2 = (x1 * sn + x2 * cs) * ksc;
                float ef = lf * (float)(c + 1), eb = lb * (float)(64 - c);
                if (which) { ef = -ef; eb = -eb; }
                const float gf = expf(ef), gb = expf(eb);
                const size_t o = (size_t)m * 256 + head * 64 + fr_;
                bf16_t* df = which ? KGf : QGf; bf16_t* db = which ? KGb : QGb;
                *(GA1 bf16_t*)(df + o) = f2bf(y1 * gf); *(GA1 bf16_t*)(df + o + 32) = f2bf(y2 * gf); *(GA1 bf16_t*)(db + o) = f2bf(y1 * gb); *(GA1 bf16_t*)(db + o + 32) = f2bf(y2 * gb);
            }
        }
        if (c == 0) {
            const int n = s >> 6;
#pragma unroll
            for (int e8 = 0; e8 < 8; ++e8) { const int e = lane + 64 * e8, dir = e >> 8, hd = (e >> 6) & 3, d = e & 63;
                const float lg = dir ? (hd == 0 ? lgb[0] : hd == 1 ? lgb[1] : hd == 2 ? lgb[2] : lgb[3]) : (hd == 0 ? lgf[0] : hd == 1 ? lgf[1] : hd == 2 ? lgf[2] : lgf[3]);
                (dir ? DECb : DECf)[((size_t)(b * 4 + hd) * 64 + n) * 64 + d] = expf(lg * 64.f); }
        }
    }
}

__device__ __forceinline__ void prep1_phase(const bf16_t* P, const float* LR, const float* w2f, const float* bf_, const float* w2b, const float* bb_, bf16_t* QGf, bf16_t* KGf, bf16_t* QGb, bf16_t* KGb,
                                            float* DECf, float* DECb, int tid, LAS unsigned char* lds, int bid, int G) {
    const int ch = tid & 127, tg = __builtin_amdgcn_readfirstlane(tid >> 7);
    LAS float* tot = (LAS float*)lds;
    LAS float* lrs = (LAS float*)(lds + 4096);
    typedef float f32x2v __attribute__((ext_vector_type(2)));
    f32x2v lrv; unsigned short qraw[16], kraw[16];
    float wcol[16]; float bias = 0.f; int key = -1;
#define P1_LOADS(IT, LV, QR, KR) do { const int dir_ = (IT) & 1, h_ = ((IT) >> 1) & 3, chunk_ = ((IT) >> 3) & 63, b_ = (IT) >> 9; const size_t tb_ = (size_t)b_ * SEQ + chunk_ * 64; \
        LV = *(const GA1 f32x2v*)(LR + (tb_ + (tid >> 3)) * 32 + dir_ * 16 + (tid & 7) * 2); \
        _Pragma("unroll") for (int i_ = 0; i_ < 16; ++i_) { QR[i_] = *(const GA1 bf16_t*)(P + (tb_ + tg * 16 + i_) * PP + h_ * 128 + ch); KR[i_] = *(const GA1 bf16_t*)(P + (tb_ + tg * 16 + i_) * PP + 512 + h_ * 128 + ch); } } while (0)
    if (bid < 4096) P1_LOADS(bid, lrv, qraw, kraw);
#pragma unroll 1
    for (int it = bid; it < 4096; it += G) {
        const int dir = it & 1, h = (it >> 1) & 3, chunk = (it >> 3) & 63, b = it >> 9;
        if ((it & 7) != key) {
            const float* w2 = dir ? w2b : w2f;
#pragma unroll
            for (int r = 0; r < 16; ++r) wcol[r] = *(const GA1 float*)(w2 + r * 512 + h * 128 + ch);
            bias = *(const GA1 float*)((dir ? bb_ : bf_) + h * 128 + ch); key = it & 7;
        }
        bf16_t* QG = dir ? QGb : QGf; bf16_t* KG = dir ? KGb : KGf;
        const size_t t0 = (size_t)b * SEQ + chunk * 64 + tg * 16;
        *(LAS f32x2v*)(lrs + (tid >> 3) * 16 + (tid & 7) * 2) = lrv;
        __syncthreads();
        f32x2v nlrv = lrv; unsigned short nq[16], nk[16];
#pragma unroll
        for (int i = 0; i < 16; ++i) { nq[i] = qraw[i]; nk[i] = kraw[i]; }
        if (it + G < 4096) P1_LOADS(it + G, nlrv, nq, nk);
        float cum[16];
#pragma unroll
        for (int i = 0; i < 16; ++i) {
            const LAS f32x4* lr = (const LAS f32x4*)(lrs + (tg * 16 + i) * 16);
            const f32x4 l0 = lr[0], l1 = lr[1], l2 = lr[2], l3 = lr[3];
            float z = bias;
            z += l0[0] * wcol[0] + l0[1] * wcol[1] + l0[2] * wcol[2] + l0[3] * wcol[3];
            z += l1[0] * wcol[4] + l1[1] * wcol[5] + l1[2] * wcol[6] + l1[3] * wcol[7];
            z += l2[0] * wcol[8] + l2[1] * wcol[9] + l2[2] * wcol[10] + l2[3] * wcol[11];
            z += l3[0] * wcol[12] + l3[1] * wcol[13] + l3[2] * wcol[14] + l3[3] * wcol[15];
            { const float e = __builtin_amdgcn_exp2f(-fabsf(z) * 1.4426950408889634f);
              cum[i] = (fminf(z, 0.f) * 1.4426950408889634f - __builtin_amdgcn_logf(1.f + e)) * (1.f / 16.f); }
        }
        float total;
        if (!dir) {
#pragma unroll
            for (int i = 1; i < 16; ++i) cum[i] += cum[i - 1];
            total = cum[15];
        } else {
#pragma unroll
            for (int i = 14; i >= 0; --i) cum[i] += cum[i + 1];
            total = cum[0];
        }
        tot[tg * 128 + ch] = total;
        __syncthreads();
        const float s0 = tot[ch], s1 = tot[128 + ch], s2 = tot[256 + ch], s3 = tot[384 + ch];
        float off;
        if (!dir) off = tg == 0 ? 0.f : tg == 1 ? s0 : tg == 2 ? s0 + s1 : (s0 + s1) + s2;
        else off = tg == 3 ? 0.f : tg == 2 ? s3 : tg == 1 ? s3 + s2 : (s3 + s2) + s1;
#pragma unroll
        for (int i = 0; i < 16; ++i) {
            const float c = cum[i] + off;
            const float qv = bf2f(qraw[i]), kv = bf2f(kraw[i]);
            *(GA1 bf16_t*)(QG + (t0 + i) * 512 + h * 128 + ch) = f2bf(qv * __builtin_amdgcn_exp2f(c));
            *(GA1 bf16_t*)(KG + (t0 + i) * 512 + h * 128 + ch) = f2bf(kv * __builtin_amdgcn_exp2f(-c));
        }
        if (tg == 0) *(GA1 float*)((dir ? DECb : DECf) + ((size_t)(b * 4 + h) * 64 + chunk) * 128 + ch) = __builtin_amdgcn_exp2f((s0 + s1) + (s2 + s3));
        lrv = nlrv;
#pragma unroll
        for (int i = 0; i < 16; ++i) { qraw[i] = nq[i]; kraw[i] = nk[i]; }
    }
#undef P1_LOADS
}
#define XB_TMO      128
#define XB_XCNT(j)  (256  + 64 * (j))
#define XB_XSUB(j)  (1280 + 64 * (j))
#define XB_XGEN(j)  (2304 + 64 * (j))
#define XB_TOP      3328
#define XB_TOPGEN   3392
#define XCD_BAR_WORDS 3456
#define XB_SPIN_CAP (1u << 18)

__device__ __forceinline__ unsigned xb_ld(unsigned* p)              { return __hip_atomic_load(p, __ATOMIC_RELAXED, __HIP_MEMORY_SCOPE_AGENT); }
__device__ __forceinline__ unsigned xb_add(unsigned* p, unsigned v) { return __hip_atomic_fetch_add(p, v, __ATOMIC_RELAXED, __HIP_MEMORY_SCOPE_AGENT); }
__device__ __forceinline__ unsigned xb_xcc_id() { return (unsigned)__builtin_amdgcn_s_getreg((3 << 11) | 20) & 0xFu; }
#define XB_SPIN(cond, bar) do { unsigned _sp = 0; while (cond) { __builtin_amdgcn_s_sleep(1); \
    if ((++_sp & 255u) == 0u) { if (xb_ld(&(bar)[XB_TMO])) break; if (_sp > XB_SPIN_CAP) { atomicAdd(&(bar)[XB_TMO], 1u); break; } } } } while (0)

struct XcdBarrier {
    unsigned* bar; unsigned x;
    volatile LAS unsigned* st;
};

__device__ __forceinline__ XcdBarrier xcd_barrier_post(unsigned* bar, volatile LAS unsigned* st) {
    XcdBarrier b; b.bar = bar; b.x = xb_xcc_id(); b.st = st;
    if (threadIdx.x == 0) (void)xb_add(&bar[XB_XCNT(b.x)], 1u);
    return b;
}
__device__ __forceinline__ void xcd_barrier_complete(unsigned* bar, unsigned x, unsigned& nloc, unsigned& nx) {
    const unsigned G = gridDim.x * gridDim.y * gridDim.z;
    unsigned sum, cnt, mine, sp = 0u;
    for (;;) {
        sum = 0u; cnt = 0u; mine = 0u;
#pragma unroll
        for (unsigned j = 0; j < 16; ++j) { const unsigned c = xb_ld(&bar[XB_XCNT(j)]); sum += c; cnt += (c > 0u) ? 1u : 0u; mine = (j == x) ? c : mine; }
        if (sum == G) break;
        __builtin_amdgcn_s_sleep(1);
        if ((++sp & 255u) == 0u) { if (xb_ld(&bar[XB_TMO])) break; if (sp > XB_SPIN_CAP) { atomicAdd(&bar[XB_TMO], 1u); break; } }
    }
    nloc = mine > 0u ? mine : 1u; nx = cnt > 0u ? cnt : 1u;
}

__device__ __forceinline__ void xcd_barrier(const XcdBarrier& b) {
    asm volatile("s_waitcnt vmcnt(0)" ::: "memory");
    __syncthreads();
    if (threadIdx.x == 0) {
        unsigned* bar = b.bar;
        __builtin_amdgcn_s_waitcnt(0);
        unsigned nloc = b.st[0], nx = b.st[1];
        if (nloc == 0u) { xcd_barrier_complete(bar, b.x, nloc, nx); b.st[0] = nloc; b.st[1] = nx; }
        const unsigned old = xb_add(&bar[XB_XSUB(b.x)], 1u);
        const unsigned gen = old / nloc;
        if (old + 1u == (gen + 1u) * nloc) {
            __builtin_amdgcn_fence(__ATOMIC_RELEASE, "agent");
            asm volatile("s_waitcnt vmcnt(0)" ::: "memory");
            const unsigned og = xb_add(&bar[XB_TOP], 1u);
            const unsigned tg = og / nx;
            if (og + 1u == (tg + 1u) * nx) xb_add(&bar[XB_TOPGEN], 1u);
            else XB_SPIN(xb_ld(&bar[XB_TOPGEN]) == tg, bar);
            __builtin_amdgcn_fence(__ATOMIC_ACQUIRE, "agent");
            xb_add(&bar[XB_XGEN(b.x)], 1u);
            asm volatile("s_waitcnt vmcnt(0)" ::: "memory");
        } else {
            XB_SPIN(xb_ld(&bar[XB_XGEN(b.x)]) == gen, bar);
            __builtin_amdgcn_fence(__ATOMIC_ACQUIRE, "agent");
            asm volatile("s_waitcnt vmcnt(0)" ::: "memory");
        }
    }
    __syncthreads();
}
#ifndef AT_VALU_MASK
#define AT_VALU_MASK 0x002
#endif
constexpr int AT_KP = 272, AT_VP = 320, AT_KB = 64 * AT_KP, AT_VB = 64 * AT_VP, AT_TB = AT_KB + AT_VB;
__device__ __forceinline__ void attn_unit(LAS unsigned char* lds, const bf16_t* P, bf16_t* cat, int b, int h, int qb, float lam, const float* da_norm, float post_scale) {
    int tid_ = threadIdx.x; asm volatile("" : "+v"(tid_)); const int tid = tid_, lane = tid & 63, w = __builtin_amdgcn_readfirstlane(tid >> 6), r32 = lane & 31, hi = lane >> 5;
    const int comp = w >> 2, qs = w & 3, i16 = lane & 15, qq = i16 >> 2, pp = i16 & 3, blk = (lane >> 4) & 1;
    const size_t rowb = (size_t)b * SEQ;
    const bf16_t* qp = P + (rowb + qb * 128 + qs * 32 + r32) * PP + h * 128 + comp * 64 + hi * 8;
    LAS unsigned char* Qs = lds + 2 * AT_KB + 2 * AT_VB + (w * 4 * 64 + lane) * 16;
#pragma unroll
    for (int s = 0; s < 4; ++s) *(LAS bf16x8*)(Qs + s * 1024) = *(const GA1 bf16x8*)(qp + 16 * s);
    const int srow = tid >> 4, sch = tid & 15;
    const bf16_t* kg = P + (rowb + srow) * PP + 512 + h * 128 + sch * 8;
    const bf16_t* vg = P + (rowb + srow) * PP + 1024 + h * 128 + sch * 8;
    u32x4 kr0, kr1, vr0, vr1;
#define AT_LOADK(t) do { const size_t o_ = (size_t)(t) * 64 * PP; kr0 = *(const GA1 u32x4*)(kg + o_); kr1 = *(const GA1 u32x4*)(kg + o_ + 32 * PP); } while (0)
#define AT_LOADV(t) do { const size_t o_ = (size_t)(t) * 64 * PP; vr0 = *(const GA1 u32x4*)(vg + o_); vr1 = *(const GA1 u32x4*)(vg + o_ + 32 * PP); } while (0)
#define AT_STOREK(bufi) do { LAS unsigned char* kb_ = lds + (bufi) * AT_KB; *(LAS u32x4*)(kb_ + srow * AT_KP + sch * 16) = kr0; *(LAS u32x4*)(kb_ + (srow + 32) * AT_KP + sch * 16) = kr1; } while (0)
#define AT_STOREV(bufi) do { LAS unsigned char* vb_ = lds + 2 * AT_KB + (bufi) * AT_VB; *(LAS u32x4*)(vb_ + srow * AT_VP + sch * 16) = vr0; *(LAS u32x4*)(vb_ + (srow + 32) * AT_VP + sch * 16) = vr1; } while (0)
#define AT_QK(bufi) do { const LAS unsigned char* Kc = lds + (bufi) * AT_KB; bf16x8 ka[4], kb_[4]; \
        _Pragma("unroll") for (int s = 0; s < 4; ++s) { ka[s] = *(const LAS bf16x8*)(Kc + r32 * AT_KP + comp * 128 + s * 32 + hi * 16); kb_[s] = *(const LAS bf16x8*)(Kc + (32 + r32) * AT_KP + comp * 128 + s * 32 + hi * 16); } \
        _Pragma("unroll") for (int r_ = 0; r_ < 16; ++r_) { s0[r_] = nmh; s1[r_] = nmh; } \
        _Pragma("unroll") for (int s = 0; s < 4; ++s) { const bf16x8 qv_ = *(const LAS bf16x8*)(Qs + s * 1024); s0 = __builtin_amdgcn_mfma_f32_32x32x16_bf16(ka[s], qv_, s0, 0, 0, 0); s1 = __builtin_amdgcn_mfma_f32_32x32x16_bf16(kb_[s], qv_, s1, 0, 0, 0); } } while (0)
#define AT_PV(bufi) do { const LAS unsigned char* vb0 = lds + 2 * AT_KB + (bufi) * AT_VB + (4 * hi + qq) * AT_VP + (16 * blk + 4 * pp) * 2; \
        _Pragma("unroll") for (int vb = 0; vb < 4; ++vb) { s16x4 vf_[8]; \
            _Pragma("unroll") for (int kb = 0; kb < 2; ++kb) _Pragma("unroll") for (int s2 = 0; s2 < 2; ++s2) { const LAS unsigned char* ad = vb0 + (kb * 32 + 16 * s2) * AT_VP + vb * 64; vf_[(kb * 2 + s2) * 2] = vtr(ad); vf_[(kb * 2 + s2) * 2 + 1] = vtr(ad + 8 * AT_VP); } \
            __builtin_amdgcn_sched_barrier(0); \
            _Pragma("unroll") for (int kb = 0; kb < 2; ++kb) _Pragma("unroll") for (int s2 = 0; s2 < 2; ++s2) \
                o[vb] = __builtin_amdgcn_mfma_f32_32x32x16_bf16(cat8(vf_[(kb * 2 + s2) * 2], vf_[(kb * 2 + s2) * 2 + 1]), __builtin_bit_cast(bf16x8, pw[kb][s2]), o[vb], 0, 0, 0); \
            __builtin_amdgcn_sched_barrier(0); } } while (0)
#define AT_PACK(dst) do { _Pragma("unroll") for (int s2 = 0; s2 < 2; ++s2) { \
            dst[0][s2] = (u32x4){cvtpk(s0[8 * s2 + 0], s0[8 * s2 + 1]), cvtpk(s0[8 * s2 + 2], s0[8 * s2 + 3]), cvtpk(s0[8 * s2 + 4], s0[8 * s2 + 5]), cvtpk(s0[8 * s2 + 6], s0[8 * s2 + 7])}; \
            dst[1][s2] = (u32x4){cvtpk(s1[8 * s2 + 0], s1[8 * s2 + 1]), cvtpk(s1[8 * s2 + 2], s1[8 * s2 + 3]), cvtpk(s1[8 * s2 + 4], s1[8 * s2 + 5]), cvtpk(s1[8 * s2 + 6], s1[8 * s2 + 7])}; } } while (0)
    if (w >= 4) __builtin_amdgcn_s_setprio(1);
    {
        const u32x4 k1a = *(const GA1 u32x4*)(kg + (size_t)64 * PP), k1b = *(const GA1 u32x4*)(kg + (size_t)64 * PP + 32 * PP);
        AT_LOADK(0); AT_LOADV(0); AT_STOREK(0); AT_STOREV(0);
        kr0 = k1a; kr1 = k1b; AT_STOREK(1);
    }
    __syncthreads();
    f32x16 o[4];
#pragma unroll
    for (int v = 0; v < 4; ++v)
#pragma unroll
        for (int r = 0; r < 16; ++r) o[v][r] = 0.f;
    float mhat = 0.f, l_run = 0.f, nmh = 0.f;
    f32x16 s0, s1;
    u32x4 pw[2][2];
    {
        AT_QK(0);
        float mx = fmaxf(fmaxf(s0[0], s1[0]), fmaxf(s0[1], s1[1]));
#pragma unroll
        for (int r = 2; r < 16; r += 2) mx = fmaxf(fmaxf(mx, fmaxf(s0[r], s1[r])), fmaxf(s0[r + 1], s1[r + 1]));
        mx = fmaxf(mx, __shfl_xor(mx, 32));
        mhat = mx;
        float psum = 0.f;
        nmh = -mhat;
#pragma unroll
        for (int r = 0; r < 16; ++r) { s0[r] = __builtin_amdgcn_exp2f(s0[r] - mx); s1[r] = __builtin_amdgcn_exp2f(s1[r] - mx); psum += s0[r] + s1[r]; }
        l_run = psum;
        AT_PACK(pw);
    }
    for (int t = 0; t < 63; ++t) {
        if (t + 2 < 64) AT_LOADK(t + 2);
        AT_LOADV(t + 1);
        AT_QK((t + 1) & 1);
        asm volatile("" : "+v"(s0), "+v"(s1) :: "memory");
        float psum = 0.f;
        u32x4 pwn[2][2];
        {
            const LAS unsigned char* vb0 = lds + 2 * AT_KB + (t & 1) * AT_VB + (4 * hi + qq) * AT_VP + (16 * blk + 4 * pp) * 2;
            s16x4 vfa[2][8];
#define AT_VRD(buf, vb) do { _Pragma("unroll") for (int kb = 0; kb < 2; ++kb) _Pragma("unroll") for (int s2 = 0; s2 < 2; ++s2) { \
                const LAS unsigned char* ad = vb0 + (kb * 32 + 16 * s2) * AT_VP + (vb) * 64; vfa[buf][(kb * 2 + s2) * 2] = vtr(ad); vfa[buf][(kb * 2 + s2) * 2 + 1] = vtr(ad + 8 * AT_VP); } } while (0)
            AT_VRD(0, 0);
#pragma unroll
            for (int vb = 0; vb < 4; ++vb) {
                if (vb < 3) AT_VRD((vb + 1) & 1, vb + 1);
                __builtin_amdgcn_sched_barrier(0);
#pragma unroll
                for (int q4 = 0; q4 < 4; ++q4) {
                    const int i = vb * 4 + q4, kb = q4 >> 1, s2 = q4 & 1;
                    o[vb] = __builtin_amdgcn_mfma_f32_32x32x16_bf16(cat8(vfa[vb & 1][(kb * 2 + s2) * 2], vfa[vb & 1][(kb * 2 + s2) * 2 + 1]), __builtin_bit_cast(bf16x8, pw[kb][s2]), o[vb], 0, 0, 0);
                    float e0, e1;
                    if (i < 8) { e0 = __builtin_amdgcn_exp2f(s0[2 * i]); e1 = __builtin_amdgcn_exp2f(s0[2 * i + 1]); s0[2 * i] = e0; s0[2 * i + 1] = e1; }
                    else { e0 = __builtin_amdgcn_exp2f(s1[2 * (i - 8)]); e1 = __builtin_amdgcn_exp2f(s1[2 * (i - 8) + 1]); s1[2 * (i - 8)] = e0; s1[2 * (i - 8) + 1] = e1; }
                    psum += e0 + e1;
                    pwn[i >> 3][(i >> 2) & 1][i & 3] = cvtpk(e0, e1);
                    asm volatile("" : "+v"(psum), "+v"(o[vb]) :: "memory");
                    __builtin_amdgcn_sched_barrier(0);
                }
            }
#undef AT_VRD
        }
        if (__any(psum > 4096.f)) {
            float pm = fmaxf(fmaxf(s0[0], s1[0]), fmaxf(s0[1], s1[1]));
#pragma unroll
            for (int r = 2; r < 16; r += 2) pm = fmaxf(fmaxf(pm, fmaxf(s0[r], s1[r])), fmaxf(s0[r + 1], s1[r + 1]));
            pm = fmaxf(pm, __shfl_xor(pm, 32));
            const float dl = fmaxf(__builtin_amdgcn_logf(pm), 0.f), f = __builtin_amdgcn_exp2f(-dl);
            mhat += dl; psum *= f; l_run *= f;
            nmh = -mhat;
#pragma unroll
            for (int r = 0; r < 16; ++r) { s0[r] *= f; s1[r] *= f; }
#pragma unroll
            for (int v = 0; v < 4; ++v)
#pragma unroll
                for (int r = 0; r < 16; ++r) o[v][r] *= f;
            AT_PACK(pwn);
        }
        l_run += psum;
#pragma unroll
        for (int a_ = 0; a_ < 2; ++a_)
#pragma unroll
            for (int b_ = 0; b_ < 2; ++b_) pw[a_][b_] = pwn[a_][b_];
        if (t + 2 < 64) AT_STOREK(t & 1);
        AT_STOREV((t + 1) & 1);
        __syncthreads();
    }
    AT_PV(1);
    __builtin_amdgcn_s_setprio(0);
    __syncthreads();
#undef AT_LOADK
#undef AT_LOADV
#undef AT_STOREK
#undef AT_STOREV
#undef AT_QK
#undef AT_PV
#undef AT_PACK
    const float l = l_run + __shfl_xor(l_run, 32), inv = 1.f / l;
    LAS float* ex = (LAS float*)lds;
    if (comp == 1) {
#pragma unroll
        for (int v = 0; v < 4; ++v)
#pragma unroll
            for (int r = 0; r < 16; ++r) ex[(v * 16 + r) * 256 + qs * 64 + lane] = o[v][r] * inv;
    }
    __syncthreads();
    if (comp == 0) {
        float ss = 0.f;
#pragma unroll
        for (int v = 0; v < 4; ++v)
#pragma unroll
            for (int r = 0; r < 16; ++r) { const float d = o[v][r] * inv - lam * ex[(v * 16 + r) * 256 + qs * 64 + lane]; o[v][r] = d; ss += d * d; }
        ss += __shfl_xor(ss, 32);
        const float rs = rsqrtf(ss * (1.f / 128.f) + EPS) * post_scale;
        bf16_t* op = cat + (rowb + qb * 128 + qs * 32 + r32) * D + h * 128;
        f32x4 gnv[4][4];
#pragma unroll
        for (int v = 0; v < 4; ++v)
#pragma unroll
            for (int g = 0; g < 4; ++g) gnv[v][g] = *(const GA1 f32x4*)(da_norm + v * 32 + 8 * g + 4 * hi);
#pragma unroll
        for (int v = 0; v < 4; ++v)
#pragma unroll
            for (int gp = 0; gp < 4; gp += 2) {
                const f32x4 ga = gnv[v][gp], gb = gnv[v][gp + 1];
                const unsigned ax = cvtpk(o[v][4 * gp] * rs * ga[0], o[v][4 * gp + 1] * rs * ga[1]), ay = cvtpk(o[v][4 * gp + 2] * rs * ga[2], o[v][4 * gp + 3] * rs * ga[3]);
                const unsigned bx = cvtpk(o[v][4 * gp + 4] * rs * gb[0], o[v][4 * gp + 5] * rs * gb[1]), by = cvtpk(o[v][4 * gp + 6] * rs * gb[2], o[v][4 * gp + 7] * rs * gb[3]);
                const auto r0 = __builtin_amdgcn_permlane32_swap(ax, bx, false, false), r1 = __builtin_amdgcn_permlane32_swap(ay, by, false, false);
                const u32x4 w4 = {r0[0], r1[0], r0[1], r1[1]};
                *(GA1 u32x4*)(op + v * 32 + 8 * (gp + hi)) = w4; }
    }
    __syncthreads();
}

#define GAS __attribute__((address_space(1)))
template <int DK>
__device__ __forceinline__ void walk_unit(LAS unsigned char* lds, const bf16_t* QG, const bf16_t* KG, int h, const bf16_t* Vp, const float* dec, bf16_t* Op, int opitch, int b, int dir) {
    constexpr int PQ = DK * 2 + 16, PV = 144, NCH = DK / 8, QB = 64 * PQ, VB = 64 * PV, TB = 2 * QB + VB, ST0 = 2 * TB, STB = 64 * PQ, NQ = 64 * NCH / 512, QPITCH = 4 * DK;
    static_assert(ST0 + 2 * STB <= 131072, "walk LDS");
    int tid_ = threadIdx.x; asm volatile("" : "+v"(tid_)); const int tid = tid_, lane = tid & 63, w = __builtin_amdgcn_readfirstlane(tid >> 6), r32 = lane & 31, hi = lane >> 5;
    const int i16 = lane & 15, qq = i16 >> 2, pp = i16 & 3, blk = (lane >> 4) & 1;
    u32x4 qreg[2][NQ], kreg[2][NQ], vreg[2];
    const int vrow = tid >> 3, vch = tid & 7;
#define WK_LOAD(set, n) do { const size_t t0_ = (size_t)b * SEQ + (size_t)(n) * 64; \
        _Pragma("unroll") for (int i_ = 0; i_ < NQ; ++i_) { const int id_ = tid + 512 * i_, row_ = id_ / NCH, ch_ = id_ % NCH; const size_t go_ = (t0_ + row_) * QPITCH + h * DK + ch_ * 8; \
            qreg[set][i_] = *(const GAS u32x4*)(QG + go_); kreg[set][i_] = *(const GAS u32x4*)(KG + go_); } \
        vreg[set] = *(const GAS u32x4*)(Vp + (t0_ + vrow) * PP + vch * 8); } while (0)
#define WK_STORE(set, bufi) do { LAS unsigned char* q_ = lds + (bufi) * TB; \
        _Pragma("unroll") for (int i_ = 0; i_ < NQ; ++i_) { const int id_ = tid + 512 * i_, row_ = id_ / NCH, ch_ = id_ % NCH; \
            *(LAS u32x4*)(q_ + row_ * PQ + ch_ * 16) = qreg[set][i_]; *(LAS u32x4*)(q_ + QB + row_ * PQ + ch_ * 16) = kreg[set][i_]; } \
        *(LAS u32x4*)(q_ + 2 * QB + vrow * PV + vch * 16) = vreg[set]; } while (0)
    constexpr int NB = DK / 64, NS = DK / 16;
    f32x16 sacc[NB];
#pragma unroll
    for (int j = 0; j < NB; ++j)
#pragma unroll
        for (int r = 0; r < 16; ++r) sacc[j][r] = 0.f;
    for (int e = tid; e < STB / 16; e += 512) *(LAS u32x4*)(lds + ST0 + e * 16) = (u32x4){0u, 0u, 0u, 0u};
    WK_LOAD(0, dir ? 63 : 0); WK_STORE(0, 0); WK_LOAD(0, dir ? 62 : 1); WK_LOAD(1, dir ? 61 : 2);
    const int dsd = (NB == 2 ? ((w - 4) & 3) : (((w - 4) & 3) >> 1)) * 32 + r32;
    float dl_next = *(const GAS float*)(dec + (size_t)(dir ? 63 : 0) * DK + dsd);
    __syncthreads();
    for (int i2 = 0; i2 < 64; i2 += 2)
#pragma unroll
    for (int u_ = 0; u_ < 2; ++u_) {
        const int i = i2 + u_;
        const int n = dir ? 63 - i : i;
        const float dl = dl_next;
        if (i < 63) dl_next = *(const GAS float*)(dec + (size_t)(dir ? n - 1 : n + 1) * DK + dsd);
        const size_t t0 = (size_t)b * SEQ + (size_t)n * 64;
        const LAS unsigned char* Qs = lds + u_ * TB; const LAS unsigned char* Ks = Qs + QB; const LAS unsigned char* Vs = Ks + QB;
        const LAS unsigned char* STc = lds + ST0 + u_ * STB; LAS unsigned char* STn = lds + ST0 + (u_ ^ 1) * STB;
        if (w < 4) {
            const int cb = w & 1, vb = w >> 1;
            f32x16 pt0, pt1, oacc;
#pragma unroll
            for (int r = 0; r < 16; ++r) { pt0[r] = 0.f; pt1[r] = 0.f; oacc[r] = 0.f; }
            const LAS unsigned char* vb0 = Vs + (4 * hi + qq) * PV + (vb * 32 + 16 * blk + 4 * pp) * 2;
            s16x4 vf[8];
#pragma unroll
            for (int jb = 0; jb < 2; ++jb)
#pragma unroll
                for (int s2 = 0; s2 < 2; ++s2) { const LAS unsigned char* ad = vb0 + (jb * 32 + 16 * s2) * PV; vf[(jb * 2 + s2) * 2] = vtr(ad); vf[(jb * 2 + s2) * 2 + 1] = vtr(ad + 8 * PV); }
            const LAS unsigned char* qa = Qs + (cb * 32 + r32) * PQ + hi * 16; const LAS unsigned char* ka = Ks + r32 * PQ + hi * 16; const LAS unsigned char* sa = STc + (vb * 32 + r32) * PQ + hi * 16;
            bf16x8 fq_[2], fk0[2], fk1[2], fs[2];
            fq_[0] = *(const LAS bf16x8*)qa; fk0[0] = *(const LAS bf16x8*)ka; fk1[0] = *(const LAS bf16x8*)(ka + 32 * PQ); fs[0] = *(const LAS bf16x8*)sa;
#pragma unroll
            for (int s = 0; s < NS; ++s) {
                if (s + 1 < NS) { const int o_ = (s + 1) * 32; fq_[(s + 1) & 1] = *(const LAS bf16x8*)(qa + o_); fk0[(s + 1) & 1] = *(const LAS bf16x8*)(ka + o_); fk1[(s + 1) & 1] = *(const LAS bf16x8*)(ka + 32 * PQ + o_); fs[(s + 1) & 1] = *(const LAS bf16x8*)(sa + o_); }
                __builtin_amdgcn_sched_barrier(0);
                pt0 = __builtin_amdgcn_mfma_f32_32x32x16_bf16(fk0[s & 1], fq_[s & 1], pt0, 0, 0, 0);
                pt1 = __builtin_amdgcn_mfma_f32_32x32x16_bf16(fk1[s & 1], fq_[s & 1], pt1, 0, 0, 0);
                oacc = __builtin_amdgcn_mfma_f32_32x32x16_bf16(fs[s & 1], fq_[s & 1], oacc, 0, 0, 0);
                __builtin_amdgcn_sched_barrier(0);
            }
            const int c = cb * 32 + r32;
#pragma unroll
            for (int r = 0; r < 16; ++r) { const int j0 = crow(r, hi), j1 = 32 + j0;
                const bool k0_ = dir ? (j0 >= c) : (j0 <= c), k1_ = dir ? (j1 >= c) : (j1 <= c);
                pt0[r] = k0_ ? pt0[r] : 0.f; pt1[r] = k1_ ? pt1[r] : 0.f; }
            u32x4 pw[2][2];
#pragma unroll
            for (int s2 = 0; s2 < 2; ++s2) {
                pw[0][s2] = (u32x4){cvtpk(pt0[8 * s2 + 0], pt0[8 * s2 + 1]), cvtpk(pt0[8 * s2 + 2], pt0[8 * s2 + 3]), cvtpk(pt0[8 * s2 + 4], pt0[8 * s2 + 5]), cvtpk(pt0[8 * s2 + 6], pt0[8 * s2 + 7])};
                pw[1][s2] = (u32x4){cvtpk(pt1[8 * s2 + 0], pt1[8 * s2 + 1]), cvtpk(pt1[8 * s2 + 2], pt1[8 * s2 + 3]), cvtpk(pt1[8 * s2 + 4], pt1[8 * s2 + 5]), cvtpk(pt1[8 * s2 + 6], pt1[8 * s2 + 7])};
            }
#pragma unroll
            for (int jb = 0; jb < 2; ++jb)
#pragma unroll
                for (int s2 = 0; s2 < 2; ++s2)
                    oacc = __builtin_amdgcn_mfma_f32_32x32x16_bf16(cat8(vf[(jb * 2 + s2) * 2], vf[(jb * 2 + s2) * 2 + 1]), __builtin_bit_cast(bf16x8, pw[jb][s2]), oacc, 0, 0, 0);
            bf16_t* op = Op + (t0 + c) * (size_t)opitch + vb * 32;
#pragma unroll
            for (int gp = 0; gp < 4; gp += 2) {
                const unsigned ax = cvtpk(oacc[4 * gp], oacc[4 * gp + 1]), ay = cvtpk(oacc[4 * gp + 2], oacc[4 * gp + 3]), bx = cvtpk(oacc[4 * gp + 4], oacc[4 * gp + 5]), by = cvtpk(oacc[4 * gp + 6], oacc[4 * gp + 7]);
                const auto r0 = __builtin_amdgcn_permlane32_swap(ax, bx, false, false), r1 = __builtin_amdgcn_permlane32_swap(ay, by, false, false);
                const u32x4 w4 = {r0[0], r1[0], r0[1], r1[1]};
                *(GAS u32x4*)(op + 8 * (gp + hi)) = w4; }
        } else {
            const int sdb = w - 4;
            {
                const int sd = NB == 2 ? sdb : (sdb >> 1), sv0 = NB == 2 ? 0 : (sdb & 1);
                const LAS unsigned char* kb0 = Ks + (8 * hi + qq) * PQ + (sd * 32 + 16 * blk + 4 * pp) * 2;
                s16x4 kf[8];
#pragma unroll
                for (int ks = 0; ks < 4; ++ks) { kf[2 * ks] = vtr(kb0 + 16 * ks * PQ); kf[2 * ks + 1] = vtr(kb0 + (16 * ks + 4) * PQ); }
#pragma unroll
                for (int j = 0; j < NB; ++j) {
                    const int sv = sv0 + j;
                    const LAS unsigned char* va0 = Vs + (8 * hi + qq) * PV + (sv * 32 + 16 * blk + 4 * pp) * 2;
                    s16x4 af[8];
#pragma unroll
                    for (int ks = 0; ks < 4; ++ks) { af[2 * ks] = vtr(va0 + 16 * ks * PV); af[2 * ks + 1] = vtr(va0 + (16 * ks + 4) * PV); }
#pragma unroll
                    for (int ks = 0; ks < 4; ++ks) sacc[j] = __builtin_amdgcn_mfma_f32_32x32x16_bf16(cat8(af[2 * ks], af[2 * ks + 1]), cat8(kf[2 * ks], kf[2 * ks + 1]), sacc[j], 0, 0, 0);
#pragma unroll
                    for (int r = 0; r < 16; ++r) { sacc[j][r] *= dl; *(LAS bf16_t*)(STn + (sv * 32 + crow(r, hi)) * PQ + (sd * 32 + r32) * 2) = f2bf(sacc[j][r]); }
                }
            }
        }
        if (i < 63) { WK_STORE(u_, (u_ + 1) & 1); if (i < 61) WK_LOAD(u_, dir ? n - 3 : n + 3); }
        __syncthreads();
    }
#undef WK_LOAD
#undef WK_STORE
}

template <int NPL>
__device__ __forceinline__ void post_phase(bf16_t* of, const bf16_t* ob, const bf16_t* gt, const float* gain, int gw, int NGW, int lane) {
    float gn[NPL];
#pragma unroll
    for (int i = 0; i < NPL; ++i) gn[i] = gain[(lane & 15) * NPL + i];
    constexpr int R = 4;
    for (int m0 = gw; m0 < T; m0 += R * NGW) {
        u32x4 a[R][NPL / 8], bq[R][NPL / 8], gg[R][NPL / 8];
#pragma unroll
        for (int q = 0; q < R; ++q) { const int m = (m0 + q * NGW) < T ? (m0 + q * NGW) : m0;
#pragma unroll
            for (int c = 0; c < NPL / 8; ++c) { a[q][c] = *(const GA1 u32x4*)(of + (size_t)m * D + lane * NPL + 8 * c); bq[q][c] = *(const GA1 u32x4*)(ob + (size_t)m * PP + lane * NPL + 8 * c); gg[q][c] = *(const GA1 u32x4*)(gt + (size_t)m * PP + lane * NPL + 8 * c); } }
#pragma unroll
        for (int q = 0; q < R; ++q) { const int m = m0 + q * NGW; if (m >= T) break;
            float v[NPL], g[NPL]; float ss = 0.f;
#pragma unroll
            for (int c = 0; c < NPL / 8; ++c)
#pragma unroll
                for (int e = 0; e < 4; ++e) { v[8 * c + 2 * e] = bflo(a[q][c][e]) + bflo(bq[q][c][e]); v[8 * c + 2 * e + 1] = bfhi(a[q][c][e]) + bfhi(bq[q][c][e]); g[8 * c + 2 * e] = bflo(gg[q][c][e]); g[8 * c + 2 * e + 1] = bfhi(gg[q][c][e]); }
#pragma unroll
            for (int i = 0; i < NPL; ++i) ss += v[i] * v[i];
            ss += __shfl_xor(ss, 1); ss += __shfl_xor(ss, 2); ss += __shfl_xor(ss, 4); ss += __shfl_xor(ss, 8);
            const float rs = rsqrtf(ss * (1.f / (16.f * NPL)) + EPS);
            bf16_t* pf = of + (size_t)m * D + lane * NPL;
#pragma unroll
            for (int c = 0; c < NPL / 8; ++c) { u32x4 o;
#pragma unroll
                for (int e = 0; e < 4; ++e) { const int i0 = 8 * c + 2 * e; o[e] = cvtpk(v[i0] * rs * gn[i0] * silu_f(g[i0]), v[i0 + 1] * rs * gn[i0 + 1] * silu_f(g[i0 + 1])); }
                *(GA1 u32x4*)(pf + 8 * c) = o; }
        }
    }
}

#ifdef NO_SW
#define GEMM_SW if (0)
#else
#define GEMM_SW
#endif
#ifdef NO_RES
#define GEMM_RES if (0)
#else
#define GEMM_RES
#endif
#ifdef NO_PROJ
#define GEMM_PROJ if (0)
#else
#define GEMM_PROJ
#endif
constexpr int LDS_BYTES = 147456;
struct Args { const void* in[30]; float* out; unsigned char* ws; };
#define INF(i) ((const float*)args.in[i])

constexpr int NPHASE = 20;
#ifndef DBG_STOP
#define DBG_STOP NPHASE
#endif
__global__ void __launch_bounds__(512, 2) mega_fwd(Args args) {
    extern __shared__ __attribute__((aligned(16))) unsigned char lds_raw[];
    LAS unsigned char* lds = (LAS unsigned char*)lds_raw;
    cg::grid_group grid = cg::this_grid();
    volatile LAS unsigned* MISC = (volatile LAS unsigned*)(lds + 131072 + 320);
    if (threadIdx.x < 64) MISC[threadIdx.x] = 0u;
    __syncthreads();
    grid.sync();
    XcdBarrier bar = xcd_barrier_post((unsigned*)args.ws + 4096, MISC + 8);
    if (threadIdx.x == 0) { const unsigned x_ = xb_xcc_id(); const unsigned r_ = __hip_atomic_fetch_add((unsigned*)args.ws + 64 + x_, 1u, __ATOMIC_RELAXED, __HIP_MEMORY_SCOPE_AGENT); MISC[20] = r_; MISC[21] = x_; MISC[22] = blockIdx.x; }
    __syncthreads();
#pragma unroll 1
    for (int ph = 0; ph < NPHASE; ++ph) {
        if (ph == 1) {
            if (threadIdx.x == 0) { bool ok_ = gridDim.x == 256;
                for (int j = 0; j < 8; ++j) ok_ = ok_ && (__hip_atomic_load((unsigned*)args.ws + 64 + j, __ATOMIC_RELAXED, __HIP_MEMORY_SCOPE_AGENT) == 32u);
                if (ok_) MISC[22] = MISC[20] * 8u + MISC[21]; }
            __syncthreads();
        }
        int tid_ = threadIdx.x; asm volatile("" : "+v"(tid_)); int bid_ = (int)__builtin_amdgcn_readfirstlane((int)MISC[22]); asm volatile("" : "+s"(bid_));
        const int tid = tid_, lane = tid & 63, wave = __builtin_amdgcn_readfirstlane(tid >> 6);
        const int G = gridDim.x, gw = bid_ * 8 + wave, NGW = G * 8;
        unsigned char* ws = args.ws; asm volatile("" : "+s"(ws));
        float* xfin = (float*)(ws + WS_C);
        bf16_t* A = (bf16_t*)(ws + WS_A); bf16_t* B = (bf16_t*)(ws + WS_B);
        bf16_t* XB = (bf16_t*)args.out;
        bf16_t* QGf = (bf16_t*)(ws + WS_C); bf16_t* KGf = (bf16_t*)(ws + WS_C + 32 * MiB); bf16_t* QGb = (bf16_t*)(ws + WS_C + 64 * MiB); bf16_t* KGb = (bf16_t*)(ws + WS_C + 96 * MiB);
        float* LR = (float*)(ws + WS_LR); float* DECf = (float*)(ws + WS_DEC); float* DECb = (float*)(ws + WS_DEC + 1 * MiB);
        float* SSB = (float*)(ws + WS_SS);
        const int layer = ph > 9 ? 1 : 0, step = (ph == 0 || ph == NPHASE - 1) ? -1 : (ph - 1) - 9 * layer;
        if (ph >= DBG_STOP && ph != NPHASE - 1) {
        } else if (ph == 0) {
            {
            LAS float* scr = (LAS float*)(lds + wave * 16384);
            int it = gw;
#pragma unroll 1
            for (int f = 0; f < 4; ++f) {
                const int ly = f >> 1, which = f & 1;
                const float* wg = INF(which ? 7 : 3) + (size_t)ly * D * FF; const float* wu = INF(which ? 8 : 4) + (size_t)ly * D * FF; const float* wd = INF(which ? 9 : 5) + (size_t)ly * FF * D;
                const float* gn = INF(which ? 6 : 2) + ly * D;
                bf16_t* gu = (bf16_t*)(ws + WS_WGU) + (size_t)f * 5632 * 1024; bf16_t* dn = (bf16_t*)(ws + WS_WD) + (size_t)f * 1024 * 2816;
                constexpr int IG = 16 * 88, ID = 44 * 32;
                for (; it < IG; it += NGW) tr_item(wg, D, FF, gu, 1, 1.f, 0, 0, gn, scr, it, lane);
                it -= IG;
                for (; it < IG; it += NGW) tr_item(wu, D, FF, gu, 2, 1.f, 0, 0, gn, scr, it, lane);
                it -= IG;
                for (; it < ID; it += NGW) tr_item(wd, FF, D, dn, 0, 1.f, 0, 0, nullptr, scr, it, lane);
                it -= ID;
            }
            {
                constexpr int I0 = 16 * 96, I1 = 16 * 32, I2 = 16 * 97;
                for (; it < I0; it += NGW) tr_item(INF(11), D, 3072, (bf16_t*)(ws + WS_WIN0), 0, 0.125f * 1.4426950408889634f, 0, 512, INF(10), scr, it, lane);
                it -= I0;
                for (; it < I1; it += NGW) tr_item(INF(20), D, D, (bf16_t*)(ws + WS_WOUT0), 0, 1.f, 0, 0, nullptr, scr, it, lane);
                it -= I1;
                for (; it < I2; it += NGW) tr_item(INF(22), D, 3104, (bf16_t*)(ws + WS_WIN1), 0, 0.08838834764831845f, 0, 512, INF(21), scr, it, lane);
                it -= I2;
                for (; it < I1; it += NGW) tr_item(INF(28), D, D, (bf16_t*)(ws + WS_WOUT1), 0, 1.f, 0, 0, nullptr, scr, it, lane);
            }
            { GA1 u32x4* z = (GA1 u32x4*)((bf16_t*)(ws + WS_WIN1) + (size_t)3104 * 1024); for (int e = bid_ * 512 + tid; e < 224 * 1024 / 8; e += G * 512) z[e] = (u32x4){0u, 0u, 0u, 0u}; }
            }
#ifdef DBL_PRO2
            {
            LAS float* scr = (LAS float*)(lds + wave * 16384);
            int it = gw;
#pragma unroll 1
            for (int f = 0; f < 4; ++f) {
                const int ly = f >> 1, which = f & 1;
                const float* wg = INF(which ? 7 : 3) + (size_t)ly * D * FF; const float* wu = INF(which ? 8 : 4) + (size_t)ly * D * FF; const float* wd = INF(which ? 9 : 5) + (size_t)ly * FF * D;
                const float* gn = INF(which ? 6 : 2) + ly * D;
                bf16_t* gu = (bf16_t*)(ws + WS_WGU) + (size_t)f * 5632 * 1024; bf16_t* dn = (bf16_t*)(ws + WS_WD) + (size_t)f * 1024 * 2816;
                constexpr int IG = 16 * 88, ID = 44 * 32;
                for (; it < IG; it += NGW) tr_item(wg, D, FF, gu, 1, 1.f, 0, 0, gn, scr, it, lane);
                it -= IG;
                for (; it < IG; it += NGW) tr_item(wu, D, FF, gu, 2, 1.f, 0, 0, gn, scr, it, lane);
                it -= IG;
                for (; it < ID; it += NGW) tr_item(wd, FF, D, dn, 0, 1.f, 0, 0, nullptr, scr, it, lane);
                it -= ID;
            }
            {
                constexpr int I0 = 16 * 96, I1 = 16 * 32, I2 = 16 * 97;
                for (; it < I0; it += NGW) tr_item(INF(11), D, 3072, (bf16_t*)(ws + WS_WIN0), 0, 0.125f * 1.4426950408889634f, 0, 512, INF(10), scr, it, lane);
                it -= I0;
                for (; it < I1; it += NGW) tr_item(INF(20), D, D, (bf16_t*)(ws + WS_WOUT0), 0, 1.f, 0, 0, nullptr, scr, it, lane);
                it -= I1;
                for (; it < I2; it += NGW) tr_item(INF(22), D, 3104, (bf16_t*)(ws + WS_WIN1), 0, 0.08838834764831845f, 0, 512, INF(21), scr, it, lane);
                it -= I2;
                for (; it < I1; it += NGW) tr_item(INF(28), D, D, (bf16_t*)(ws + WS_WOUT1), 0, 1.f, 0, 0, nullptr, scr, it, lane);
            }
            { GA1 u32x4* z = (GA1 u32x4*)((bf16_t*)(ws + WS_WIN1) + (size_t)3104 * 1024); for (int e = bid_ * 512 + tid; e < 224 * 1024 / 8; e += G * 512) z[e] = (u32x4){0u, 0u, 0u, 0u}; }
            }
#endif
            cast_phase(INF(0), XB, SSB, gw, NGW, lane);
        } else if (ph == NPHASE - 1) {
            final_phase(A, SSB + (size_t)6 * T * 16, INF(29), args.out, gw, NGW, lane);
        } else if (step == 0 || step == 7) {
            const int f = layer * 2 + (step == 7 ? 1 : 0);
            pg8::Gemm g{XB, (const bf16_t*)(ws + WS_WGU) + (size_t)f * 5632 * 1024, T, 5632, D}; pg8::StaticOrder S; S.init(T, 5632, G, bid_);
            EpiSwiglu E{B, SSB + (size_t)(3 * layer + (step == 7 ? 2 : 0)) * T * 16};
            GEMM_SW pg8::gemm_phase<EpiSwiglu, pg8::StaticOrder, true, true>(lds, g, S, E);
#ifdef DBL_GU
            GEMM_SW pg8::gemm_phase<EpiSwiglu, pg8::StaticOrder, true, true>(lds, g, S, E);
#endif
        } else if (step == 1 || step == 8 || step == 6) {
            const int f = layer * 2 + (step == 8 ? 1 : 0);
            const bf16_t* Am = step == 6 ? A : B;
            const bf16_t* Wm = step == 6 ? (const bf16_t*)(ws + (layer == 0 ? WS_WOUT0 : WS_WOUT1)) : (const bf16_t*)(ws + WS_WD) + (size_t)f * 1024 * 2816;
            pg8::Gemm g{Am, Wm, T, D, step == 6 ? D : FF}; pg8::StaticOrder S; S.init(T, D, G, bid_);
            const bool last = (layer == 1 && step == 8);
            const bf16_t* e_xb = XB; bf16_t* e_out = last ? A : XB; float e_alpha = step == 6 ? 1.0f : 0.5f; float* e_ss = SSB + (size_t)(3 * layer + (step == 1 ? 1 : step == 6 ? 2 : 3)) * T * 16;
            asm volatile("" : "+s"(e_xb), "+s"(e_out), "+s"(e_alpha), "+s"(e_ss));
            EpiRes E{e_xb, e_out, e_alpha, e_ss};
            GEMM_RES pg8::gemm_phase<EpiRes, pg8::StaticOrder, true, true>(lds, g, S, E);
        } else if (step == 2) {
            const int N = layer == 0 ? 3072 : 3328;
            pg8::Gemm g{XB, (const bf16_t*)(ws + (layer == 0 ? WS_WIN0 : WS_WIN1)), T, N, D}; pg8::StaticOrder S; S.init(T, N, G, bid_);
            EpiProj E{B, LR, SSB + (size_t)(3 * layer + 1) * T * 16};
            GEMM_PROJ pg8::gemm_phase<EpiProj, pg8::StaticOrder, true, true>(lds, g, S, E);
#ifdef DBL_PROJ
            GEMM_PROJ pg8::gemm_phase<EpiProj, pg8::StaticOrder, true, true>(lds, g, S, E);
#endif
        } else if (step == 3) {
            if (layer == 0) prep0_phase(B, (const int*)args.in[1], INF(17), INF(18), QGf, KGf, QGb, KGb, DECf, DECb, gw, NGW, lane);
            else { prep1_phase(B, LR, INF(23), INF(24), INF(25), INF(26), QGf, KGf, QGb, KGb, DECf, DECb, tid, lds, bid_, G);
#ifdef DBL_PREP1
                prep1_phase(B, LR, INF(23), INF(24), INF(25), INF(26), QGf, KGf, QGb, KGb, DECf, DECb, tid, lds, bid_, G);
#endif
 }
        } else if (step == 4) {
            if (layer == 0) {
                float s1 = 0.f, s2 = 0.f;
                for (int i = 0; i < 64; ++i) { s1 += INF(12)[i] * INF(13)[i]; s2 += INF(14)[i] * INF(15)[i]; }
                const float lam_init = 0.2f, lam = expf(s1) - expf(s2) + lam_init;
#ifndef SKIP_ATTN
#pragma unroll 1
                for (int u = bid_; u < 1024; u += G) { const int i = u >> 8, bx = u & 255, bh = (bx & 7) * 4 + i, qb = bx >> 3;
                    attn_unit(lds, B, A, bh >> 2, bh & 3, qb, lam, INF(16), 1.f - lam_init);
#ifdef DBL_ATTN
                    attn_unit(lds, B, A, bh >> 2, bh & 3, qb, lam, INF(16), 1.f - lam_init);
#endif
 }
#endif
#ifndef SKIP_WALK
#pragma unroll 1
                for (int u = bid_; u < 128; u += G) { const int x = u & 7, y = u >> 3, vs = y & 1, dir = (y >> 1) & 1, bh = x * 4 + (y >> 2), b = bh >> 2, h = bh & 3;
#define WALK0_CALL                     walk_unit<64>(lds, dir ? QGb : QGf, dir ? KGb : KGf, h, B + 2048 + h * 128 + vs * 64, (dir ? DECb : DECf) + (size_t)bh * 64 * 64, \
                                  dir ? (B + 1536 + h * 128 + vs * 64) : (A + 512 + h * 128 + vs * 64), dir ? PP : D, b, dir);
                    WALK0_CALL
#ifdef DBL_WALK
                    WALK0_CALL
#endif
 }
#endif
            } else {
#ifndef SKIP_WALK
#pragma unroll 1
                for (int u = bid_; u < 256; u += G) { const int x = u & 7, y = u >> 3, vs = y & 3, dir = (y >> 2) & 1, bh = x * 4 + (y >> 3), b = bh >> 2, h = bh & 3;
#define WALK1_CALL                     walk_unit<128>(lds, dir ? QGb : QGf, dir ? KGb : KGf, h, B + 1024 + h * 256 + vs * 64, (dir ? DECb : DECf) + (size_t)bh * 64 * 128, \
                                   dir ? (B + h * 256 + vs * 64) : (A + h * 256 + vs * 64), dir ? PP : D, b, dir);
                    WALK1_CALL
#ifdef DBL_WALK
                    WALK1_CALL
#endif
 }
#endif
            }
        } else if (step == 5) {
            if (layer == 0) post_phase<8>(A + 512, B + 1536, B + 2560, INF(19), gw, NGW, lane);
            else post_phase<16>(A, B, B + 2048, INF(27), gw, NGW, lane);
        }
        if (ph + 1 < NPHASE) xcd_barrier(bar);
#ifdef DBL_BAR
        if (ph + 1 < NPHASE) xcd_barrier(bar);
#endif
    }
}

extern "C" void kernel_launch(void* const* d_in, const int* in_sizes, int n_in, void* d_out, int out_size, void* d_ws, size_t ws_size, hipStream_t stream) {
    static int grid = 0;
    if (grid == 0) {
        if (n_in != 30 || out_size != T * D || ws_size < WS_END) { fprintf(stderr, "kernel_launch: unexpected shapes (n_in %d out %d ws %zu)\n", n_in, out_size, ws_size); grid = -1; return; }
        int dev = 0, cus = 0, per_cu = 0;
        (void)hipGetDevice(&dev); (void)hipDeviceGetAttribute(&cus, hipDeviceAttributeMultiprocessorCount, dev);
        if (hipFuncSetAttribute((const void*)mega_fwd, hipFuncAttributeMaxDynamicSharedMemorySize, LDS_BYTES) != hipSuccess) { fprintf(stderr, "kernel_launch: hipFuncSetAttribute failed\n"); }
        if (hipOccupancyMaxActiveBlocksPerMultiprocessor(&per_cu, (const void*)mega_fwd, 512, LDS_BYTES) != hipSuccess || per_cu < 1) per_cu = 1;
        (void)hipGetLastError();
        grid = cus * per_cu;
        if (grid <= 0) grid = 256;
    }
    if (grid < 0) return;
    Args a{};
    for (int i = 0; i < 30; ++i) a.in[i] = d_in[i];
    a.out = (float*)d_out; a.ws = (unsigned char*)d_ws;
    (void)hipMemsetAsync(d_ws, 0, 65536, stream);
    void* kargs[] = {&a};
    hipError_t e = hipLaunchCooperativeKernel((const void*)mega_fwd, dim3(grid), dim3(512), kargs, LDS_BYTES, stream);
    if (e != hipSuccess) fprintf(stderr, "cooperative launch failed: %s (grid %d)\n", hipGetErrorString(e), grid);
}
```

```cpp
#include <hip/hip_runtime.h>
#include <hip/hip_cooperative_groups.h>
#include <cstdio>
#include <cstdint>
namespace cg = cooperative_groups;
namespace pg8 {
#define PG8_LAS __attribute__((address_space(3)))
typedef unsigned short bf16_t;
typedef short bf16x8 __attribute__((ext_vector_type(8)));
typedef float f32x4 __attribute__((ext_vector_type(4)));
typedef unsigned u32x4 __attribute__((ext_vector_type(4)));
constexpr int BM = 256, BK = 64, HALF = 128, HTB = HALF * BK * 2  , STAGE_BYTES = 8 * HTB, NXCD = 8, WGM = 8;

__host__ __device__ __forceinline__ int lds_byte(int r, int c) { const int st = (r >> 4) * 2 + (c >> 5), rr = r & 15, cc = c & 31, ob = rr * 64 + cc * 2; return st * 1024 + (ob ^ (((ob >> 9) & 1) << 5)); }
__host__ __device__ __forceinline__ void stage_rc(int b, int& R, int& C) { const int st = b / 1024, sb = b % 1024, swz = sb ^ (((sb >> 9) & 1) << 5); R = (st >> 1) * 16 + swz / 64; C = (st & 1) * 32 + (swz % 64) / 2; }
__host__ __device__ __forceinline__ int perm32(int rho) { const int n = rho >> 4, i = rho & 15; return 8 * (i >> 2) + 4 * n + (i & 3); }

struct Unit { int pm, pn; };
struct Gemm { const bf16_t* A; const bf16_t* Bt; int M, N, K; };

struct StaticOrder {
    int nM, nN, nwg, G, c;
    __host__ __device__ void init(int M, int N, int G_, int c_) { nM = M / BM; nN = N / BM; nwg = nM * nN; G = G_; c = c_; }
    __host__ __device__ bool next(int i, Unit& u) const {
        const long L = (long)i * G + c; if (L >= nwg) return false;
        int wgid = (int)L; { const int q = nwg / NXCD, r = nwg % NXCD, xcd = wgid % NXCD, off = wgid / NXCD; wgid = (xcd < r ? xcd * (q + 1) : r * (q + 1) + (xcd - r) * q) + off; }
        const int nig = WGM * nN, gid = wgid / nig, fm = gid * WGM, gsz = (nM - fm) < WGM ? (nM - fm) : WGM;
        u.pm = fm + ((wgid % nig) % gsz); u.pn = (wgid % nig) / gsz; return true;
    }
    __device__ __forceinline__ void a_ready(const Unit&) const {}
    __device__ __forceinline__ void done(const Unit&) const {}
};
__device__ __forceinline__ unsigned cvt_pk_bf16(float lo, float hi) { unsigned r; asm volatile("v_cvt_pk_bf16_f32 %0, %1, %2" : "=v"(r) : "v"(lo), "v"(hi)); return r; }
typedef float f32x2 __attribute__((ext_vector_type(2)));
template <class Epi, class Sched, bool ALIGN_EPI = false, bool SP2 = false>
__device__ __forceinline__ void gemm_phase(PG8_LAS unsigned char* lds, const Gemm g, const Sched& S, const Epi& E) {
    int tid_ = threadIdx.x; asm volatile("" : "+v"(tid_)); const int tid = tid_, wid = __builtin_amdgcn_readfirstlane(tid >> 6), lane = tid & 63, wr = wid >> 2, wc = wid & 3, fr = lane & 15, fq = lane >> 4;
    const int K = g.K, nt = K / BK;
    unsigned voffA[2], voffB[2];
#pragma unroll
    for (int i = 0; i < 2; ++i) { int R, C; stage_rc(tid * 16 + i * 8192, R, C); const int Rb = Epi::PERM ? ((R & ~31) + perm32(R & 31)) : R;
        voffA[i] = (unsigned)(R * K + C) * 2u; voffB[i] = (unsigned)(Rb * K + C) * 2u; }
    const size_t kstep = (size_t)(BK * 2);
    const size_t hstep = (size_t)HALF * K * 2;
    const size_t tstep = 2 * hstep;
    const unsigned ldsw = (unsigned)wid * 1024u;
    const int aoff = lds_byte(wr * 64 + fr, fq * 8), boff = lds_byte(wc * 32 + fr, fq * 8);
#define PG8_SA(b, h) (((b) * 2 + (h)) * HTB)
#define PG8_SB(b, h) ((4 + (b) * 2 + (h)) * HTB)
#define PG8_STAGE(bufoff, gbase, voff) do { _Pragma("unroll") for (int _i = 0; _i < 2; ++_i) \
        __builtin_amdgcn_global_load_lds((const unsigned*)((const char*)(gbase) + (voff)[_i]), (PG8_LAS unsigned*)(lds + (bufoff) + ldsw + _i * 8192), 16, 0, 0); } while (0)
#define PG8_LDA(dst, b, h) do { _Pragma("unroll") for (int m = 0; m < 4; ++m) _Pragma("unroll") for (int k = 0; k < 2; ++k) dst[m][k] = *(const PG8_LAS bf16x8*)(lds + PG8_SA(b, h) + aoff + m * 2048 + k * 1024); } while (0)
#define PG8_LDB(dst, b, h) do { _Pragma("unroll") for (int n = 0; n < 2; ++n) _Pragma("unroll") for (int k = 0; k < 2; ++k) dst[n][k] = *(const PG8_LAS bf16x8*)(lds + PG8_SB(b, h) + boff + n * 2048 + k * 1024); } while (0)
#define PG8_MMA(ai, bj, At, Bt) do { __builtin_amdgcn_s_setprio(1); _Pragma("unroll") for (int m = 0; m < 4; ++m) _Pragma("unroll") for (int n = 0; n < 2; ++n) _Pragma("unroll") for (int k = 0; k < 2; ++k) \
        acc[ai][bj][m][n] = __builtin_amdgcn_mfma_f32_16x16x32_bf16(Bt[n][k], At[m][k], acc[ai][bj][m][n], 0, 0, 0); __builtin_amdgcn_s_setprio(0); } while (0)
#define PG8_WAIT_V(n) asm volatile("s_waitcnt vmcnt(" #n ")" ::: "memory")
#define PG8_WAIT_L(n) asm volatile("s_waitcnt lgkmcnt(" #n ")" ::: "memory")
#define PG8_BAR __builtin_amdgcn_s_barrier()
#define PG8_SCHED __builtin_amdgcn_sched_barrier(0)
    Unit cur, nxt; int ui = 0;
    if (!S.next(0, cur)) return;
    f32x4 acc[2][2][4][2];
#pragma unroll
    for (int a = 0; a < 2; ++a)
#pragma unroll
        for (int b = 0; b < 2; ++b)
#pragma unroll
            for (int m = 0; m < 4; ++m)
#pragma unroll
                for (int n = 0; n < 2; ++n) acc[a][b][m][n] = (f32x4){0.f, 0.f, 0.f, 0.f};
    bf16x8 At[4][2], B0[2][2], B1[2][2];
    const char* cA = (const char*)g.A + (size_t)cur.pm * tstep; const char* cB = (const char*)g.Bt + (size_t)cur.pn * tstep;
    S.a_ready(cur);
    if constexpr (SP2) {
        PG8_STAGE(PG8_SB(0, 0), cB, voffB); PG8_STAGE(PG8_SB(0, 1), cB + hstep, voffB); PG8_STAGE(PG8_SA(0, 0), cA, voffA); PG8_STAGE(PG8_SA(0, 1), cA + hstep, voffA);
        if (wr == 1) PG8_BAR;
        PG8_WAIT_V(2); PG8_BAR;
        PG8_STAGE(PG8_SB(1, 0), cB + kstep, voffB); PG8_STAGE(PG8_SA(1, 0), cA + kstep, voffA); PG8_STAGE(PG8_SB(1, 1), cB + hstep + kstep, voffB);
        PG8_WAIT_V(6); PG8_BAR;
    } else {
        PG8_STAGE(PG8_SB(0, 0), cB, voffB); PG8_STAGE(PG8_SA(0, 0), cA, voffA); PG8_STAGE(PG8_SB(0, 1), cB + hstep, voffB); PG8_STAGE(PG8_SA(0, 1), cA + hstep, voffA);
        if (wr == 1) PG8_BAR;
        PG8_WAIT_V(4); PG8_BAR;
        PG8_STAGE(PG8_SB(1, 0), cB + kstep, voffB); PG8_STAGE(PG8_SA(1, 0), cA + kstep, voffA); PG8_STAGE(PG8_SB(1, 1), cB + hstep + kstep, voffB);
        PG8_WAIT_V(6); PG8_BAR;
    }
    for (;;) {
        const bool has_next = S.next(ui + 1, nxt);
        const char* nA = has_next ? (const char*)g.A + (size_t)nxt.pm * tstep : cA; const char* nB = has_next ? (const char*)g.Bt + (size_t)nxt.pn * tstep : cB;
        for (int t = 0; t < nt; t += 2) {
            const bool last = (t == nt - 2);
            const char* a1 = cA + (size_t)(t + 1) * kstep;
            const char* a2 = last ? nA : cA + (size_t)(t + 2) * kstep; const char* b2 = last ? nB : cB + (size_t)(t + 2) * kstep;
            const char* a3 = a2 + kstep; const char* b3 = b2 + kstep;
            if (last && has_next) S.a_ready(nxt);
            if constexpr (SP2) {
            PG8_LDB(B0, 0, 0); PG8_LDB(B1, 0, 1); PG8_SCHED; PG8_LDA(At, 0, 0); PG8_STAGE(PG8_SA(1, 1), a1 + hstep, voffA);
            PG8_WAIT_V(8); PG8_WAIT_L(0); PG8_BAR; PG8_MMA(0, 0, At, B0); PG8_MMA(0, 1, At, B1); PG8_BAR; PG8_SCHED;
            PG8_LDA(At, 0, 1); PG8_STAGE(PG8_SB(0, 0), b2, voffB); PG8_STAGE(PG8_SB(0, 1), b2 + hstep, voffB); PG8_STAGE(PG8_SA(0, 0), a2, voffA);
            PG8_WAIT_V(8); PG8_WAIT_L(0); PG8_BAR; PG8_MMA(1, 0, At, B0); PG8_MMA(1, 1, At, B1); PG8_BAR; PG8_SCHED;
            PG8_LDB(B0, 1, 0); PG8_LDB(B1, 1, 1); PG8_SCHED; PG8_LDA(At, 1, 0); PG8_STAGE(PG8_SA(0, 1), a2 + hstep, voffA);
            PG8_WAIT_V(8); PG8_WAIT_L(0); PG8_BAR; PG8_MMA(0, 0, At, B0); PG8_MMA(0, 1, At, B1); PG8_BAR; PG8_SCHED;
            PG8_LDA(At, 1, 1); PG8_STAGE(PG8_SB(1, 0), b3, voffB); PG8_STAGE(PG8_SB(1, 1), b3 + hstep, voffB); PG8_STAGE(PG8_SA(1, 0), a3, voffA);
            PG8_WAIT_V(8); PG8_WAIT_L(0); PG8_BAR; PG8_MMA(1, 0, At, B0); PG8_MMA(1, 1, At, B1); PG8_BAR; PG8_SCHED;
            } else {
            PG8_LDB(B0, 0, 0); PG8_SCHED; PG8_LDA(At, 0, 0); PG8_STAGE(PG8_SA(1, 1), a1 + hstep, voffA);
            PG8_WAIT_L(8); PG8_BAR; PG8_WAIT_L(0); PG8_MMA(0, 0, At, B0); PG8_BAR; PG8_SCHED;
            PG8_LDB(B1, 0, 1); PG8_STAGE(PG8_SB(0, 0), b2, voffB);
            PG8_BAR; PG8_WAIT_L(0); PG8_MMA(0, 1, At, B1); PG8_BAR;
            PG8_LDA(At, 0, 1); PG8_STAGE(PG8_SA(0, 0), a2, voffA);
            PG8_BAR; PG8_WAIT_L(0); PG8_MMA(1, 0, At, B0); PG8_BAR; PG8_SCHED;
            PG8_STAGE(PG8_SB(0, 1), b2 + hstep, voffB);
            PG8_WAIT_V(6); PG8_BAR; PG8_MMA(1, 1, At, B1); PG8_BAR;
            PG8_LDB(B0, 1, 0); PG8_SCHED; PG8_LDA(At, 1, 0); PG8_STAGE(PG8_SA(0, 1), a2 + hstep, voffA);
            PG8_WAIT_L(8); PG8_BAR; PG8_WAIT_L(0); PG8_MMA(0, 0, At, B0); PG8_BAR; PG8_SCHED;
            PG8_LDB(B1, 1, 1); PG8_STAGE(PG8_SB(1, 0), b3, voffB);
            PG8_BAR; PG8_WAIT_L(0); PG8_MMA(0, 1, At, B1); PG8_BAR;
            PG8_LDA(At, 1, 1); PG8_STAGE(PG8_SA(1, 0), a3, voffA);
            PG8_BAR; PG8_WAIT_L(0); PG8_MMA(1, 0, At, B0); PG8_BAR; PG8_SCHED;
            PG8_STAGE(PG8_SB(1, 1), b3 + hstep, voffB);
            PG8_WAIT_V(6); PG8_BAR; PG8_MMA(1, 1, At, B1); PG8_BAR;
            }
        }
        if constexpr (ALIGN_EPI) { if (wr == 0) PG8_BAR; }
        if constexpr (!Epi::AFTER_DRAIN) { E(acc, cur, wr, wc, fr, fq); S.done(cur); }
        if (!has_next) break;
#pragma unroll
        for (int a = 0; a < 2; ++a)
#pragma unroll
            for (int b = 0; b < 2; ++b)
#pragma unroll
                for (int m = 0; m < 4; ++m)
#pragma unroll
                    for (int n = 0; n < 2; ++n) acc[a][b][m][n] = (f32x4){0.f, 0.f, 0.f, 0.f};
        cur = nxt; cA = nA; cB = nB; ++ui;
        if constexpr (ALIGN_EPI) { if (wr == 1) PG8_BAR; }
    }
    PG8_WAIT_V(0);
    if constexpr (!ALIGN_EPI) { if (wr == 0) PG8_BAR; }
    PG8_BAR;
    if constexpr (Epi::AFTER_DRAIN) { E.fused(acc, cur, wr, wc, fr, fq, lds, wid, lane); S.done(cur); }
#undef PG8_SA
#undef PG8_SB
#undef PG8_STAGE
#undef PG8_LDA
#undef PG8_LDB
#undef PG8_MMA
#undef PG8_WAIT_V
#undef PG8_WAIT_L
#undef PG8_BAR
#undef PG8_SCHED
}
}
#define LAS __attribute__((address_space(3)))
#define GA1 __attribute__((address_space(1)))
typedef unsigned short bf16_t;
typedef short bf16x8 __attribute__((ext_vector_type(8)));
typedef short s16x4 __attribute__((ext_vector_type(4)));
typedef short v4i16_t __attribute__((ext_vector_type(4)));
typedef float f32x4 __attribute__((ext_vector_type(4)));
typedef float f32x16 __attribute__((ext_vector_type(16)));
typedef unsigned u32x4 __attribute__((ext_vector_type(4)));
typedef unsigned u32x2 __attribute__((ext_vector_type(2)));

constexpr int T = 32768, D = 1024, FF = 2816, SEQ = 4096, PP = 3072;
constexpr float EPS = 1e-6f;
constexpr size_t MiB = 1u << 20;
constexpr size_t WS_WGU = 1 * MiB;
constexpr size_t WS_WD = WS_WGU + 44 * MiB;
constexpr size_t WS_WIN0 = WS_WD + 22 * MiB;
constexpr size_t WS_WOUT0 = WS_WIN0 + 6 * MiB;
constexpr size_t WS_WIN1 = WS_WOUT0 + 2 * MiB;
constexpr size_t WS_WOUT1 = WS_WIN1 + 7 * MiB;
constexpr size_t WS_A = 84 * MiB;
constexpr size_t WS_B = 148 * MiB;
constexpr size_t WS_C = 340 * MiB;
constexpr size_t WS_LR = 468 * MiB;
constexpr size_t WS_DEC = 472 * MiB;
constexpr size_t WS_SS = 476 * MiB;
constexpr size_t WS_END = 490 * MiB;
static_assert(WS_WOUT1 + 2 * MiB <= WS_A, "ws map");

typedef float f32x2_t __attribute__((ext_vector_type(2))); typedef __bf16 bf16x2_t __attribute__((ext_vector_type(2)));
__device__ __forceinline__ unsigned cvtpk(float lo, float hi) { f32x2_t v = {lo, hi}; bf16x2_t b = __builtin_convertvector(v, bf16x2_t); return __builtin_bit_cast(unsigned, b); }
__device__ __forceinline__ float bf2f(bf16_t b) { return __uint_as_float((unsigned)b << 16); }
__device__ __forceinline__ float bflo(unsigned w) { return __uint_as_float(w << 16); }
__device__ __forceinline__ float bfhi(unsigned w) { return __uint_as_float(w & 0xffff0000u); }
__device__ __forceinline__ bf16_t f2bf(float f) { return (bf16_t)(cvtpk(f, 0.f) & 0xffffu); }
__device__ __forceinline__ int crow(int r, int hi) { return (r & 3) + 8 * (r >> 2) + 4 * hi; }
__device__ __forceinline__ s16x4 vtr(const LAS unsigned char* p) { return __builtin_bit_cast(s16x4, __builtin_amdgcn_ds_read_tr16_b64_v4i16((LAS v4i16_t*)p)); }
__device__ __forceinline__ bf16x8 cat8(s16x4 a, s16x4 b) { return (bf16x8){a[0], a[1], a[2], a[3], b[0], b[1], b[2], b[3]}; }
__device__ __forceinline__ float wave_sum(float v) {
#pragma unroll
    for (int o = 1; o < 64; o <<= 1) v += __shfl_xor(v, o);
    return v;
}
__device__ __forceinline__ float silu_f(float g) { return g * __builtin_amdgcn_rcpf(1.f + __expf(-g)); }
__device__ __forceinline__ void sincos_rev(float ang, float& sn, float& cs) {
    const double rev = (double)ang * 0.15915494309189535; const float fr = (float)(rev - floor(rev));
    sn = __builtin_amdgcn_sinf(fr); cs = __builtin_amdgcn_cosf(fr);
}
__device__ __forceinline__ float logsig(float z) { return fminf(z, 0.f) - log1pf(expf(-fabsf(z))); }

__device__ __forceinline__ void rows_rs(const float* SS, int row0, int fq, float (&rsv)[2][4]) {
    f32x4 p[2][4];
#pragma unroll
    for (int ai = 0; ai < 2; ++ai)
#pragma unroll
        for (int m = 0; m < 4; ++m) p[ai][m] = *(const GA1 f32x4*)(SS + (size_t)(row0 + ai * 128 + m * 16) * 16 + fq * 4);
#pragma unroll
    for (int ai = 0; ai < 2; ++ai)
#pragma unroll
        for (int m = 0; m < 4; ++m) { float s = (p[ai][m][0] + p[ai][m][1]) + (p[ai][m][2] + p[ai][m][3]); s += __shfl_xor(s, 16); s += __shfl_xor(s, 32); rsv[ai][m] = rsqrtf(s * (1.f / D) + EPS); }
}
struct EpiSwiglu {
    static constexpr bool PERM = true, AFTER_DRAIN = false;
    bf16_t* O; const float* SS;
    __device__ __forceinline__ void operator()(const f32x4 (&acc)[2][2][4][2], const pg8::Unit& u, int wr, int wc, int fr, int fq) const {
        const int row0 = u.pm * 256 + wr * 64 + fr, f0 = u.pn * 128 + wc * 32 + 8 * fq;
        float rsv[2][4]; rows_rs(SS, row0, fq, rsv);
#pragma unroll
        for (int ai = 0; ai < 2; ++ai)
#pragma unroll
            for (int m = 0; m < 4; ++m) {
                const int row = row0 + ai * 128 + m * 16;
                const float rs = rsv[ai][m];
                bf16_t* p = O + (size_t)row * FF + f0;
                const f32x4 g0 = acc[ai][0][m][0] * rs, g1 = acc[ai][0][m][1] * rs, u0 = acc[ai][1][m][0] * rs, u1 = acc[ai][1][m][1] * rs;
                u32x4 w;
                w.x = cvtpk(silu_f(g0[0]) * u0[0], silu_f(g0[1]) * u0[1]); w.y = cvtpk(silu_f(g0[2]) * u0[2], silu_f(g0[3]) * u0[3]);
                w.z = cvtpk(silu_f(g1[0]) * u1[0], silu_f(g1[1]) * u1[1]); w.w = cvtpk(silu_f(g1[2]) * u1[2], silu_f(g1[3]) * u1[3]);
                *(GA1 u32x4*)p = w;
            }
    }
};
struct EpiRes {
    static constexpr bool PERM = true, AFTER_DRAIN = false;
    const bf16_t* XB; bf16_t* XW; float alpha; float* SSo;
    __device__ __forceinline__ void operator()(const f32x4 (&acc)[2][2][4][2], const pg8::Unit& u, int wr, int wc, int fr, int fq) const {
        const int row0 = u.pm * 256 + wr * 64 + fr, col0 = u.pn * 256 + wc * 32 + 8 * fq;
        const bf16_t* XB = this->XB; bf16_t* XW = this->XW; float alpha = this->alpha; float* SSo = this->SSo;
        asm volatile("" : "+s"(XB), "+s"(XW), "+s"(alpha), "+s"(SSo));
#pragma unroll
        for (int ai = 0; ai < 2; ++ai) {
            u32x4 bs[4][2];
#pragma unroll
            for (int m = 0; m < 4; ++m)
#pragma unroll
                for (int bj = 0; bj < 2; ++bj) bs[m][bj] = *(const GA1 u32x4*)(XB + (size_t)(row0 + ai * 128 + m * 16) * D + col0 + bj * 128);
#pragma unroll
            for (int m = 0; m < 4; ++m) {
                const int row = row0 + ai * 128 + m * 16;
                const size_t off = (size_t)row * D + col0;
                float ss = 0.f;
#pragma unroll
                for (int bj = 0; bj < 2; ++bj) { const size_t o = off + bj * 128; const u32x4 b = bs[m][bj];
                    const f32x4 v0 = (f32x4){bflo(b.x), bfhi(b.x), bflo(b.y), bfhi(b.y)} + alpha * acc[ai][bj][m][0], v1 = (f32x4){bflo(b.z), bfhi(b.z), bflo(b.w), bfhi(b.w)} + alpha * acc[ai][bj][m][1];
                    u32x4 w; w.x = cvtpk(v0[0], v0[1]); w.y = cvtpk(v0[2], v0[3]); w.z = cvtpk(v1[0], v1[1]); w.w = cvtpk(v1[2], v1[3]); *(GA1 u32x4*)(XW + o) = w;
                    ss += ((v0[0] * v0[0] + v0[1] * v0[1]) + (v0[2] * v0[2] + v0[3] * v0[3])) + ((v1[0] * v1[0] + v1[1] * v1[1]) + (v1[2] * v1[2] + v1[3] * v1[3])); }
                ss += __shfl_xor(ss, 16); ss += __shfl_xor(ss, 32); if (fq == 0) *(GA1 float*)(SSo + (size_t)row * 16 + u.pn * 4 + wc) = ss;
            }
        }
    }
};
struct EpiProj {
    static constexpr bool PERM = true, AFTER_DRAIN = false;
    bf16_t* O; float* LR; const float* SS;
    __device__ __forceinline__ void operator()(const f32x4 (&acc)[2][2][4][2], const pg8::Unit& u, int wr, int wc, int fr, int fq) const {
        const int row0 = u.pm * 256 + wr * 64 + fr;
        float rsv[2][4]; rows_rs(SS, row0, fq, rsv);
        if (u.pn >= 12) {
            if (wc == 0) {
#pragma unroll
                for (int ai = 0; ai < 2; ++ai)
#pragma unroll
                    for (int m = 0; m < 4; ++m) { const int row = row0 + ai * 128 + m * 16; const float rs = rsv[ai][m];
                        float* p = LR + (size_t)row * 32 + 8 * fq; *(GA1 f32x4*)p = acc[ai][0][m][0] * rs; *(GA1 f32x4*)(p + 4) = acc[ai][0][m][1] * rs; }
            }
            return;
        }
        const int col0 = u.pn * 256 + wc * 32 + 8 * fq;
#pragma unroll
        for (int ai = 0; ai < 2; ++ai)
#pragma unroll
            for (int m = 0; m < 4; ++m) {
                const int row = row0 + ai * 128 + m * 16; const float rs = rsv[ai][m];
                bf16_t* p = O + (size_t)row * PP + col0;
#pragma unroll
                for (int bj = 0; bj < 2; ++bj) { const f32x4 v0 = acc[ai][bj][m][0] * rs, v1 = acc[ai][bj][m][1] * rs; u32x4 w; w.x = cvtpk(v0[0], v0[1]); w.y = cvtpk(v0[2], v0[3]); w.z = cvtpk(v1[0], v1[1]); w.w = cvtpk(v1[2], v1[3]); *(GA1 u32x4*)(p + bj * 128) = w; }
            }
    }
};

__device__ __forceinline__ void tr_item(const float* W, int K, int N, bf16_t* WT, int mode, float sc, int sc_lo, int sc_hi, const float* gain, LAS float* scr, int item, int lane) {
    const int nblk = N / 32, kb = item / nblk, nb = item % nblk, k0 = 64 * kb, n0 = 32 * nb;
#pragma unroll 8
    for (int i = 0; i < 32; ++i) { const int kk = 2 * i + (lane >> 5); scr[kk * 33 + (lane & 31)] = W[(size_t)(k0 + kk) * N + n0 + (lane & 31)]; }
    asm volatile("s_waitcnt lgkmcnt(0)" ::: "memory");
    const int d0 = mode ? (256 * (n0 >> 7) + (n0 & 127) + (mode == 2 ? 128 : 0)) : n0;
    const float s = (n0 >= sc_lo && n0 < sc_hi) ? sc : 1.f;
    const int c = lane & 7;
    f32x4 ga = {s, s, s, s}, gb = {s, s, s, s};
    if (gain) { ga = ga * *(const GA1 f32x4*)(gain + k0 + 8 * c); gb = gb * *(const GA1 f32x4*)(gain + k0 + 8 * c + 4); }
#pragma unroll
    for (int j = 0; j < 4; ++j) { const int n = (lane >> 3) + 8 * j; const LAS float* p = scr + (8 * c) * 33 + n;
        u32x4 o; o.x = cvtpk(p[0 * 33] * ga[0], p[1 * 33] * ga[1]); o.y = cvtpk(p[2 * 33] * ga[2], p[3 * 33] * ga[3]); o.z = cvtpk(p[4 * 33] * gb[0], p[5 * 33] * gb[1]); o.w = cvtpk(p[6 * 33] * gb[2], p[7 * 33] * gb[3]);
        *(GA1 u32x4*)(WT + (size_t)(d0 + n) * K + k0 + 8 * c) = o; }
    asm volatile("s_waitcnt lgkmcnt(0)" ::: "memory");
}

template <bool OUT_F32>
__device__ __forceinline__ void norm_phase(const float* src, const float* gain, bf16_t* dst, float* dstf, int gw, int NGW, int lane) {
    f32x4 g[4];
#pragma unroll
    for (int j = 0; j < 4; ++j) g[j] = ((const f32x4*)gain)[lane + 64 * j];
    for (int m0 = gw; m0 < T; m0 += 4 * NGW) {
        f32x4 v[4][4]; float ss[4];
#pragma unroll
        for (int q = 0; q < 4; ++q) { const int m = m0 + q * NGW; const GA1 f32x4* xr = (const GA1 f32x4*)(src + (size_t)(m < T ? m : m0) * D) + lane;
#pragma unroll
            for (int j = 0; j < 4; ++j) v[q][j] = xr[64 * j]; }
#pragma unroll
        for (int q = 0; q < 4; ++q) { float a = 0.f;
#pragma unroll
            for (int j = 0; j < 4; ++j) a += (v[q][j].x * v[q][j].x + v[q][j].y * v[q][j].y) + (v[q][j].z * v[q][j].z + v[q][j].w * v[q][j].w);
            ss[q] = a; }
#pragma unroll
        for (int o = 1; o < 64; o <<= 1)
#pragma unroll
            for (int q = 0; q < 4; ++q) ss[q] += __shfl_xor(ss[q], o);
#pragma unroll
        for (int q = 0; q < 4; ++q) { const int m = m0 + q * NGW; if (m >= T) break;
            const float r = rsqrtf(ss[q] * (1.f / D) + EPS);
            if (OUT_F32) { GA1 f32x4* o = (GA1 f32x4*)(dstf + (size_t)m * D) + lane;
#pragma unroll
                for (int j = 0; j < 4; ++j) o[64 * j] = v[q][j] * r * g[j];
            } else { GA1 u32x2* o = (GA1 u32x2*)(dst + (size_t)m * D) + lane;
#pragma unroll
                for (int j = 0; j < 4; ++j) { const f32x4 y = v[q][j] * r * g[j]; u32x2 w; w.x = cvtpk(y.x, y.y); w.y = cvtpk(y.z, y.w); o[64 * j] = w; } }
        }
    }
}

__device__ __forceinline__ void final_phase(const bf16_t* src, const float* SS, const float* gain, float* dstf, int gw, int NGW, int lane) {
    f32x4 g[4];
#pragma unroll
    for (int j = 0; j < 4; ++j) g[j] = ((const f32x4*)gain)[lane * 4 + j];
    for (int m0 = gw; m0 < T; m0 += 4 * NGW) {
        u32x4 v[4][2]; float pr[4];
#pragma unroll
        for (int q = 0; q < 4; ++q) { const int m = (m0 + q * NGW) < T ? (m0 + q * NGW) : m0; const GA1 u32x4* xr = (const GA1 u32x4*)(src + (size_t)m * D + lane * 16); v[q][0] = xr[0]; v[q][1] = xr[1];
            pr[q] = SS[(size_t)m * 16 + (lane & 15)]; }
#pragma unroll
        for (int q = 0; q < 4; ++q) { float a = pr[q]; a += __shfl_xor(a, 1); a += __shfl_xor(a, 2); a += __shfl_xor(a, 4); a += __shfl_xor(a, 8); pr[q] = rsqrtf(a * (1.f / D) + EPS); }
#pragma unroll
        for (int q = 0; q < 4; ++q) { const int m = m0 + q * NGW; if (m >= T) break;
            GA1 f32x4* o = (GA1 f32x4*)(dstf + (size_t)m * D + lane * 16); const float r = pr[q];
#pragma unroll
            for (int c = 0; c < 2; ++c) { const u32x4 b = v[q][c];
                o[2 * c] = (f32x4){bflo(b.x), bfhi(b.x), bflo(b.y), bfhi(b.y)} * r * g[2 * c]; o[2 * c + 1] = (f32x4){bflo(b.z), bfhi(b.z), bflo(b.w), bfhi(b.w)} * r * g[2 * c + 1]; }
        }
    }
}

__device__ __forceinline__ void cast_phase(const float* src, bf16_t* dst, float* SSo, int gw, int NGW, int lane) {
    for (int m0 = gw; m0 < T; m0 += 4 * NGW) {
        f32x4 v[4][4]; float ss[4];
#pragma unroll
        for (int q = 0; q < 4; ++q) { const int m = m0 + q * NGW; const GA1 f32x4* xr = (const GA1 f32x4*)(src + (size_t)(m < T ? m : m0) * D) + lane;
#pragma unroll
            for (int j = 0; j < 4; ++j) v[q][j] = xr[64 * j]; }
#pragma unroll
        for (int q = 0; q < 4; ++q) { float a = 0.f;
#pragma unroll
            for (int j = 0; j < 4; ++j) a += (v[q][j].x * v[q][j].x + v[q][j].y * v[q][j].y) + (v[q][j].z * v[q][j].z + v[q][j].w * v[q][j].w);
            ss[q] = a; }
#pragma unroll
        for (int o = 1; o < 64; o <<= 1)
#pragma unroll
            for (int q = 0; q < 4; ++q) ss[q] += __shfl_xor(ss[q], o);
#pragma unroll
        for (int q = 0; q < 4; ++q) { const int m = m0 + q * NGW; if (m >= T) break;
            GA1 u32x2* o = (GA1 u32x2*)(dst + (size_t)m * D) + lane;
#pragma unroll
            for (int j = 0; j < 4; ++j) { u32x2 w; w.x = cvtpk(v[q][j].x, v[q][j].y); w.y = cvtpk(v[q][j].z, v[q][j].w); o[64 * j] = w; }
            if (lane < 16) SSo[(size_t)m * 16 + lane] = lane == 0 ? ss[q] : 0.f; }
    }
}

__device__ __forceinline__ void prep0_phase(bf16_t* P, const int* pos, const float* logit_f, const float* logit_b, bf16_t* QGf, bf16_t* KGf, bf16_t* QGb, bf16_t* KGb,
                                            float* DECf, float* DECb, int gw, int NGW, int lane) {
    const int fa = lane & 7, fr_ = lane & 31, hh = lane >> 5;
    const float inva = exp2f(-18.931568569324174f * (float)(2 * fa) * (1.f / 16.f));
    const float invr = exp2f(-13.287712379549449f * (float)(2 * fr_) * (1.f / 64.f));
    float lgf[4], lgb[4];
#pragma unroll
    for (int h = 0; h < 4; ++h) { lgf[h] = logsig(logit_f[h]); lgb[h] = logsig(logit_b[h]); }
    for (int m = gw; m < T; m += NGW) {
        const int b = m >> 12, s = m & 4095, c = s & 63;
        const float posf = (float)pos[s];
        bf16_t* row = P + (size_t)m * PP;
        unsigned short ar[2][2], rr[4][2];
#pragma unroll
        for (int i = 0; i < 2; ++i) { const int col = i * 512 + (lane >> 3) * 64 + fa; ar[i][0] = *(const GA1 bf16_t*)(row + col); ar[i][1] = *(const GA1 bf16_t*)(row + col + 8); }
#pragma unroll
        for (int i = 0; i < 4; ++i) { const int which = i >> 1, head = ((i & 1) << 1) | hh, col = 1536 + which * 256 + head * 64 + fr_; rr[i][0] = *(const GA1 bf16_t*)(row + col); rr[i][1] = *(const GA1 bf16_t*)(row + col + 32); }
        {
            float sn, cs; sincos_rev(posf * inva, sn, cs);
#pragma unroll
            for (int i = 0; i < 2; ++i) { const int col = i * 512 + (lane >> 3) * 64 + fa; const float x1 = bf2f(ar[i][0]), x2 = bf2f(ar[i][1]);
                *(GA1 bf16_t*)(row + col) = f2bf(x1 * cs - x2 * sn); *(GA1 bf16_t*)(row + col + 8) = f2bf(x1 * sn + x2 * cs); }
        }
        {
            float sn, cs; sincos_rev(posf * invr, sn, cs);
#pragma unroll
            for (int i = 0; i < 4; ++i) {
                const int which = i >> 1, head = ((i & 1) << 1) | hh;
                const float lf = hh ? lgf[((i & 1) << 1) | 1] : lgf[(i & 1) << 1], lb = hh ? lgb[((i & 1) << 1) | 1] : lgb[(i & 1) << 1];
                const float x1 = bf2f(rr[i][0]), x2 = bf2f(rr[i][1]);
                const float ksc = which ? 0.125f : 1.f;
                const float y1 = (x1 * cs - x2 * sn) * ksc, y2 = (x1 * sn + x2 * cs) * ksc;
                float ef = lf * (float)(c + 1), eb = lb * (float)(64 - c);
                if (which) { ef = -ef; eb = -eb; }
                const float gf = expf(ef), gb = expf(eb);
                const size_t o = (size_t)m * 256 + head * 64 + fr_;
                bf16_t* df = which ? KGf : QGf; bf16_t* db = which ? KGb : QGb;
                *(GA1 bf16_t*)(df + o) = f2bf(y1 * gf); *(GA1 bf16_t*)(df + o + 32) = f2bf(y2 * gf); *(GA1 bf16_t*)(db + o) = f2bf(y1 * gb); *(GA1 bf16_t*)(db + o + 32) = f2bf(y2 * gb);
            }
        }
        if (c == 0) {
            const int n = s >> 6;
#pragma unroll
            for (int e8 = 0; e8 < 8; ++e8) { const int e = lane + 64 * e8, dir = e >> 8, hd = (e >> 6) & 3, d = e & 63;
                const float lg = dir ? (hd == 0 ? lgb[0] : hd == 1 ? lgb[1] : hd == 2 ? lgb[2] : lgb[3]) : (hd == 0 ? lgf[0] : hd == 1 ? lgf[1] : hd == 2 ? lgf[2] : lgf[3]);
                (dir ? DECb : DECf)[((size_t)(b * 4 + hd) * 64 + n) * 64 + d] = expf(lg * 64.f); }
        }
    }
}

__device__ __forceinline__ void prep1_phase(const bf16_t* P, const float* LR, const float* w2f, const float* bf_, const float* w2b, const float* bb_, bf16_t* QGf, bf16_t* KGf, bf16_t* QGb, bf16_t* KGb,
                                            float* DECf, float* DECb, int tid, LAS unsigned char* lds, int bid, int G) {
    const int ch = tid & 127, tg = __builtin_amdgcn_readfirstlane(tid >> 7);
    LAS float* tot = (LAS float*)lds;
    LAS float* lrs = (LAS float*)(lds + 4096);
    typedef float f32x2v __attribute__((ext_vector_type(2)));
    f32x2v lrv; unsigned short qraw[16], kraw[16];
    float wcol[16]; float bias = 0.f; int key = -1;
#define P1_LOADS(IT, LV, QR, KR) do { const int dir_ = (IT) & 1, h_ = ((IT) >> 1) & 3, chunk_ = ((IT) >> 3) & 63, b_ = (IT) >> 9; const size_t tb_ = (size_t)b_ * SEQ + chunk_ * 64; \
        LV = *(const GA1 f32x2v*)(LR + (tb_ + (tid >> 3)) * 32 + dir_ * 16 + (tid & 7) * 2); \
        _Pragma("unroll") for (int i_ = 0; i_ < 16; ++i_) { QR[i_] = *(const GA1 bf16_t*)(P + (tb_ + tg * 16 + i_) * PP + h_ * 128 + ch); KR[i_] = *(const GA1 bf16_t*)(P + (tb_ + tg * 16 + i_) * PP + 512 + h_ * 128 + ch); } } while (0)
    if (bid < 4096) P1_LOADS(bid, lrv, qraw, kraw);
#pragma unroll 1
    for (int it = bid; it < 4096; it += G) {
        const int dir = it & 1, h = (it >> 1) & 3, chunk = (it >> 3) & 63, b = it >> 9;
        if ((it & 7) != key) {
            const float* w2 = dir ? w2b : w2f;
#pragma unroll
            for (int r = 0; r < 16; ++r) wcol[r] = *(const GA1 float*)(w2 + r * 512 + h * 128 + ch);
            bias = *(const GA1 float*)((dir ? bb_ : bf_) + h * 128 + ch); key = it & 7;
        }
        bf16_t* QG = dir ? QGb : QGf; bf16_t* KG = dir ? KGb : KGf;
        const size_t t0 = (size_t)b * SEQ + chunk * 64 + tg * 16;
        *(LAS f32x2v*)(lrs + (tid >> 3) * 16 + (tid & 7) * 2) = lrv;
        __syncthreads();
        f32x2v nlrv = lrv; unsigned short nq[16], nk[16];
#pragma unroll
        for (int i = 0; i < 16; ++i) { nq[i] = qraw[i]; nk[i] = kraw[i]; }
        if (it + G < 4096) P1_LOADS(it + G, nlrv, nq, nk);
        float cum[16];
#pragma unroll
        for (int i = 0; i < 16; ++i) {
            const LAS f32x4* lr = (const LAS f32x4*)(lrs + (tg * 16 + i) * 16);
            const f32x4 l0 = lr[0], l1 = lr[1], l2 = lr[2], l3 = lr[3];
            float z = bias;
            z += l0[0] * wcol[0] + l0[1] * wcol[1] + l0[2] * wcol[2] + l0[3] * wcol[3];
            z += l1[0] * wcol[4] + l1[1] * wcol[5] + l1[2] * wcol[6] + l1[3] * wcol[7];
            z += l2[0] * wcol[8] + l2[1] * wcol[9] + l2[2] * wcol[10] + l2[3] * wcol[11];
            z += l3[0] * wcol[12] + l3[1] * wcol[13] + l3[2] * wcol[14] + l3[3] * wcol[15];
            { const float e = __builtin_amdgcn_exp2f(-fabsf(z) * 1.4426950408889634f);
              cum[i] = (fminf(z, 0.f) * 1.4426950408889634f - __builtin_amdgcn_logf(1.f + e)) * (1.f / 16.f); }
        }
        float total;
        if (!dir) {
#pragma unroll
            for (int i = 1; i < 16; ++i) cum[i] += cum[i - 1];
            total = cum[15];
        } else {
#pragma unroll
            for (int i = 14; i >= 0; --i) cum[i] += cum[i + 1];
            total = cum[0];
        }
        tot[tg * 128 + ch] = total;
        __syncthreads();
        const float s0 = tot[ch], s1 = tot[128 + ch], s2 = tot[256 + ch], s3 = tot[384 + ch];
        float off;
        if (!dir) off = tg == 0 ? 0.f : tg == 1 ? s0 : tg == 2 ? s0 + s1 : (s0 + s1) + s2;
        else off = tg == 3 ? 0.f : tg == 2 ? s3 : tg == 1 ? s3 + s2 : (s3 + s2) + s1;
        const int odd = ch & 1;
#pragma unroll
        for (int i = 0; i < 16; i += 2) {
            const float c0 = cum[i] + off, c1 = cum[i + 1] + off;
            const unsigned q0 = f2bf(bf2f(qraw[i]) * __builtin_amdgcn_exp2f(c0)), q1 = f2bf(bf2f(qraw[i + 1]) * __builtin_amdgcn_exp2f(c1));
            const unsigned k0 = f2bf(bf2f(kraw[i]) * __builtin_amdgcn_exp2f(-c0)), k1 = f2bf(bf2f(kraw[i + 1]) * __builtin_amdgcn_exp2f(-c1));
            const unsigned mine_q = odd ? q1 : q0, send_q = odd ? q0 : q1, mine_k = odd ? k1 : k0, send_k = odd ? k0 : k1;
            const unsigned got_q = (unsigned)__builtin_amdgcn_update_dpp(0, (int)send_q, 0xB1, 0xF, 0xF, true), got_k = (unsigned)__builtin_amdgcn_update_dpp(0, (int)send_k, 0xB1, 0xF, 0xF, true);
            const unsigned wq = odd ? (got_q | (mine_q << 16)) : (mine_q | (got_q << 16)), wk = odd ? (got_k | (mine_k << 16)) : (mine_k | (got_k << 16));
            const size_t o_ = (t0 + i + odd) * 512 + h * 128 + (ch & ~1);
            *(GA1 unsigned*)(QG + o_) = wq; *(GA1 unsigned*)(KG + o_) = wk;
        }
        if (tg == 0) *(GA1 float*)((dir ? DECb : DECf) + ((size_t)(b * 4 + h) * 64 + chunk) * 128 + ch) = __builtin_amdgcn_exp2f((s0 + s1) + (s2 + s3));
        lrv = nlrv;
#pragma unroll
        for (int i = 0; i < 16; ++i) { qraw[i] = nq[i]; kraw[i] = nk[i]; }
    }
#undef P1_LOADS
}
#define XB_TMO      128
#define XB_XCNT(j)  (256  + 64 * (j))
#define XB_XSUB(j)  (1280 + 64 * (j))
#define XB_XGEN(j)  (2304 + 64 * (j))
#define XB_TOP      3328
#define XB_TOPGEN   3392
#define XCD_BAR_WORDS 3456
#define XB_SPIN_CAP (1u << 18)

__device__ __forceinline__ unsigned xb_ld(unsigned* p)              { return __hip_atomic_load(p, __ATOMIC_RELAXED, __HIP_MEMORY_SCOPE_AGENT); }
__device__ __forceinline__ unsigned xb_add(unsigned* p, unsigned v) { return __hip_atomic_fetch_add(p, v, __ATOMIC_RELAXED, __HIP_MEMORY_SCOPE_AGENT); }
__device__ __forceinline__ unsigned xb_xcc_id() { return (unsigned)__builtin_amdgcn_s_getreg((3 << 11) | 20) & 0xFu; }
#define XB_SPIN(cond, bar) do { unsigned _sp = 0; while (cond) { __builtin_amdgcn_s_sleep(1); \
    if ((++_sp & 255u) == 0u) { if (xb_ld(&(bar)[XB_TMO])) break; if (_sp > XB_SPIN_CAP) { atomicAdd(&(bar)[XB_TMO], 1u); break; } } } } while (0)

struct XcdBarrier {
    unsigned* bar; unsigned x;
    volatile LAS unsigned* st;
};

__device__ __forceinline__ XcdBarrier xcd_barrier_post(unsigned* bar, volatile LAS unsigned* st) {
    XcdBarrier b; b.bar = bar; b.x = xb_xcc_id(); b.st = st;
    if (threadIdx.x == 0) (void)xb_add(&bar[XB_XCNT(b.x)], 1u);
    return b;
}
__device__ __forceinline__ void xcd_barrier_complete(unsigned* bar, unsigned x, unsigned& nloc, unsigned& nx) {
    const unsigned G = gridDim.x * gridDim.y * gridDim.z;
    unsigned sum, cnt, mine, sp = 0u;
    for (;;) {
        sum = 0u; cnt = 0u; mine = 0u;
#pragma unroll
        for (unsigned j = 0; j < 16; ++j) { const unsigned c = xb_ld(&bar[XB_XCNT(j)]); sum += c; cnt += (c > 0u) ? 1u : 0u; mine = (j == x) ? c : mine; }
        if (sum == G) break;
        __builtin_amdgcn_s_sleep(1);
        if ((++sp & 255u) == 0u) { if (xb_ld(&bar[XB_TMO])) break; if (sp > XB_SPIN_CAP) { atomicAdd(&bar[XB_TMO], 1u); break; } }
    }
    nloc = mine > 0u ? mine : 1u; nx = cnt > 0u ? cnt : 1u;
}

__device__ __forceinline__ void xcd_barrier(const XcdBarrier& b) {
    asm volatile("s_waitcnt vmcnt(0)" ::: "memory");
    __syncthreads();
    if (threadIdx.x == 0) {
        unsigned* bar = b.bar;
        __builtin_amdgcn_s_waitcnt(0);
        unsigned nloc = b.st[0], nx = b.st[1];
        if (nloc == 0u) { xcd_barrier_complete(bar, b.x, nloc, nx); b.st[0] = nloc; b.st[1] = nx; }
        const unsigned old = xb_add(&bar[XB_XSUB(b.x)], 1u);
        const unsigned gen = old / nloc;
        if (old + 1u == (gen + 1u) * nloc) {
            __builtin_amdgcn_fence(__ATOMIC_RELEASE, "agent");
            asm volatile("s_waitcnt vmcnt(0)" ::: "memory");
            const unsigned og = xb_add(&bar[XB_TOP], 1u);
            const unsigned tg = og / nx;
            if (og + 1u == (tg + 1u) * nx) xb_add(&bar[XB_TOPGEN], 1u);
            else XB_SPIN(xb_ld(&bar[XB_TOPGEN]) == tg, bar);
            __builtin_amdgcn_fence(__ATOMIC_ACQUIRE, "agent");
            xb_add(&bar[XB_XGEN(b.x)], 1u);
            asm volatile("s_waitcnt vmcnt(0)" ::: "memory");
        } else {
            XB_SPIN(xb_ld(&bar[XB_XGEN(b.x)]) == gen, bar);
            __builtin_amdgcn_fence(__ATOMIC_ACQUIRE, "agent");
            asm volatile("s_waitcnt vmcnt(0)" ::: "memory");
        }
    }
    __syncthreads();
}
#ifndef AT_VALU_MASK
#define AT_VALU_MASK 0x002
#endif
constexpr int AT_KP = 272, AT_VP = 320, AT_KB = 64 * AT_KP, AT_VB = 64 * AT_VP, AT_TB = AT_KB + AT_VB;
__device__ __forceinline__ void attn_unit(LAS unsigned char* lds, const bf16_t* P, bf16_t* cat, int b, int h, int qb, float lam, const float* da_norm, float post_scale) {
    int tid_ = threadIdx.x; asm volatile("" : "+v"(tid_)); const int tid = tid_, lane = tid & 63, w = __builtin_amdgcn_readfirstlane(tid >> 6), r32 = lane & 31, hi = lane >> 5;
    const int comp = w >> 2, qs = w & 3, i16 = lane & 15, qq = i16 >> 2, pp = i16 & 3, blk = (lane >> 4) & 1;
    const size_t rowb = (size_t)b * SEQ;
    const bf16_t* qp = P + (rowb + qb * 128 + qs * 32 + r32) * PP + h * 128 + comp * 64 + hi * 8;
    LAS unsigned char* Qs = lds + 2 * AT_KB + 2 * AT_VB + (w * 4 * 64 + lane) * 16;
#pragma unroll
    for (int s = 0; s < 4; ++s) *(LAS bf16x8*)(Qs + s * 1024) = *(const GA1 bf16x8*)(qp + 16 * s);
    const int srow = tid >> 4, sch = tid & 15;
    const bf16_t* kg = P + (rowb + srow) * PP + 512 + h * 128 + sch * 8;
    const bf16_t* vg = P + (rowb + srow) * PP + 1024 + h * 128 + sch * 8;
    u32x4 kr0, kr1, vr0, vr1;
#define AT_LOADK(t) do { const size_t o_ = (size_t)(t) * 64 * PP; kr0 = *(const GA1 u32x4*)(kg + o_); kr1 = *(const GA1 u32x4*)(kg + o_ + 32 * PP); } while (0)
#define AT_LOADV(t) do { const size_t o_ = (size_t)(t) * 64 * PP; vr0 = *(const GA1 u32x4*)(vg + o_); vr1 = *(const GA1 u32x4*)(vg + o_ + 32 * PP); } while (0)
#define AT_STOREK(bufi) do { LAS unsigned char* kb_ = lds + (bufi) * AT_KB; *(LAS u32x4*)(kb_ + srow * AT_KP + sch * 16) = kr0; *(LAS u32x4*)(kb_ + (srow + 32) * AT_KP + sch * 16) = kr1; } while (0)
#define AT_STOREV(bufi) do { LAS unsigned char* vb_ = lds + 2 * AT_KB + (bufi) * AT_VB; *(LAS u32x4*)(vb_ + srow * AT_VP + sch * 16) = vr0; *(LAS u32x4*)(vb_ + (srow + 32) * AT_VP + sch * 16) = vr1; } while (0)
#define AT_QK(bufi) do { const LAS unsigned char* Kc = lds + (bufi) * AT_KB; bf16x8 ka[4], kb_[4]; \
        _Pragma("unroll") for (int s = 0; s < 4; ++s) { ka[s] = *(const LAS bf16x8*)(Kc + r32 * AT_KP + comp * 128 + s * 32 + hi * 16); kb_[s] = *(const LAS bf16x8*)(Kc + (32 + r32) * AT_KP + comp * 128 + s * 32 + hi * 16); } \
        _Pragma("unroll") for (int r_ = 0; r_ < 16; ++r_) { s0[r_] = nmh; s1[r_] = nmh; } \
        _Pragma("unroll") for (int s = 0; s < 4; ++s) { const bf16x8 qv_ = *(const LAS bf16x8*)(Qs + s * 1024); s0 = __builtin_amdgcn_mfma_f32_32x32x16_bf16(ka[s], qv_, s0, 0, 0, 0); s1 = __builtin_amdgcn_mfma_f32_32x32x16_bf16(kb_[s], qv_, s1, 0, 0, 0); } } while (0)
#define AT_PV(bufi) do { const LAS unsigned char* vb0 = lds + 2 * AT_KB + (bufi) * AT_VB + (4 * hi + qq) * AT_VP + (16 * blk + 4 * pp) * 2; \
        _Pragma("unroll") for (int vb = 0; vb < 4; ++vb) { s16x4 vf_[8]; \
            _Pragma("unroll") for (int kb = 0; kb < 2; ++kb) _Pragma("unroll") for (int s2 = 0; s2 < 2; ++s2) { const LAS unsigned char* ad = vb0 + (kb * 32 + 16 * s2) * AT_VP + vb * 64; vf_[(kb * 2 + s2) * 2] = vtr(ad); vf_[(kb * 2 + s2) * 2 + 1] = vtr(ad + 8 * AT_VP); } \
            __builtin_amdgcn_sched_barrier(0); \
            _Pragma("unroll") for (int kb = 0; kb < 2; ++kb) _Pragma("unroll") for (int s2 = 0; s2 < 2; ++s2) \
                o[vb] = __builtin_amdgcn_mfma_f32_32x32x16_bf16(cat8(vf_[(kb * 2 + s2) * 2], vf_[(kb * 2 + s2) * 2 + 1]), __builtin_bit_cast(bf16x8, pw[kb][s2]), o[vb], 0, 0, 0); \
            __builtin_amdgcn_sched_barrier(0); } } while (0)
#define AT_PACK(dst) do { _Pragma("unroll") for (int s2 = 0; s2 < 2; ++s2) { \
            dst[0][s2] = (u32x4){cvtpk(s0[8 * s2 + 0], s0[8 * s2 + 1]), cvtpk(s0[8 * s2 + 2], s0[8 * s2 + 3]), cvtpk(s0[8 * s2 + 4], s0[8 * s2 + 5]), cvtpk(s0[8 * s2 + 6], s0[8 * s2 + 7])}; \
            dst[1][s2] = (u32x4){cvtpk(s1[8 * s2 + 0], s1[8 * s2 + 1]), cvtpk(s1[8 * s2 + 2], s1[8 * s2 + 3]), cvtpk(s1[8 * s2 + 4], s1[8 * s2 + 5]), cvtpk(s1[8 * s2 + 6], s1[8 * s2 + 7])}; } } while (0)
    if (w >= 4) __builtin_amdgcn_s_setprio(1);
    {
        const u32x4 k1a = *(const GA1 u32x4*)(kg + (size_t)64 * PP), k1b = *(const GA1 u32x4*)(kg + (size_t)64 * PP + 32 * PP);
        AT_LOADK(0); AT_LOADV(0); AT_STOREK(0); AT_STOREV(0);
        kr0 = k1a; kr1 = k1b; AT_STOREK(1);
    }
    __syncthreads();
    f32x16 o[4];
#pragma unroll
    for (int v = 0; v < 4; ++v)
#pragma unroll
        for (int r = 0; r < 16; ++r) o[v][r] = 0.f;
    float mhat = 0.f, l_run = 0.f, nmh = 0.f;
    f32x16 s0, s1;
    u32x4 pw[2][2];
    {
        AT_QK(0);
        float mx = fmaxf(fmaxf(s0[0], s1[0]), fmaxf(s0[1], s1[1]));
#pragma unroll
        for (int r = 2; r < 16; r += 2) mx = fmaxf(fmaxf(mx, fmaxf(s0[r], s1[r])), fmaxf(s0[r + 1], s1[r + 1]));
        mx = fmaxf(mx, __shfl_xor(mx, 32));
        mhat = mx;
        float psum = 0.f;
        nmh = -mhat;
#pragma unroll
        for (int r = 0; r < 16; ++r) { s0[r] = __builtin_amdgcn_exp2f(s0[r] - mx); s1[r] = __builtin_amdgcn_exp2f(s1[r] - mx); psum += s0[r] + s1[r]; }
        l_run = psum;
        AT_PACK(pw);
    }
    for (int t = 0; t < 63; ++t) {
        if (t + 2 < 64) AT_LOADK(t + 2);
        AT_LOADV(t + 1);
        AT_QK((t + 1) & 1);
        asm volatile("" : "+v"(s0), "+v"(s1) :: "memory");
        float psum = 0.f;
        u32x4 pwn[2][2];
        {
            const LAS unsigned char* vb0 = lds + 2 * AT_KB + (t & 1) * AT_VB + (4 * hi + qq) * AT_VP + (16 * blk + 4 * pp) * 2;
            s16x4 vfa[2][8];
#define AT_VRD(buf, vb) do { _Pragma("unroll") for (int kb = 0; kb < 2; ++kb) _Pragma("unroll") for (int s2 = 0; s2 < 2; ++s2) { \
                const LAS unsigned char* ad = vb0 + (kb * 32 + 16 * s2) * AT_VP + (vb) * 64; vfa[buf][(kb * 2 + s2) * 2] = vtr(ad); vfa[buf][(kb * 2 + s2) * 2 + 1] = vtr(ad + 8 * AT_VP); } } while (0)
            AT_VRD(0, 0);
#pragma unroll
            for (int vb = 0; vb < 4; ++vb) {
                if (vb < 3) AT_VRD((vb + 1) & 1, vb + 1);
                __builtin_amdgcn_sched_barrier(0);
#pragma unroll
                for (int q4 = 0; q4 < 4; ++q4) {
                    const int i = vb * 4 + q4, kb = q4 >> 1, s2 = q4 & 1;
                    o[vb] = __builtin_amdgcn_mfma_f32_32x32x16_bf16(cat8(vfa[vb & 1][(kb * 2 + s2) * 2], vfa[vb & 1][(kb * 2 + s2) * 2 + 1]), __builtin_bit_cast(bf16x8, pw[kb][s2]), o[vb], 0, 0, 0);
                    float e0, e1;
                    if (i < 8) { e0 = __builtin_amdgcn_exp2f(s0[2 * i]); e1 = __builtin_amdgcn_exp2f(s0[2 * i + 1]); s0[2 * i] = e0; s0[2 * i + 1] = e1; }
                    else { e0 = __builtin_amdgcn_exp2f(s1[2 * (i - 8)]); e1 = __builtin_amdgcn_exp2f(s1[2 * (i - 8) + 1]); s1[2 * (i - 8)] = e0; s1[2 * (i - 8) + 1] = e1; }
                    psum += e0 + e1;
                    pwn[i >> 3][(i >> 2) & 1][i & 3] = cvtpk(e0, e1);
                    asm volatile("" : "+v"(psum), "+v"(o[vb]) :: "memory");
                    __builtin_amdgcn_sched_barrier(0);
                }
            }
#undef AT_VRD
        }
        if (__any(psum > 4096.f)) {
            float pm = fmaxf(fmaxf(s0[0], s1[0]), fmaxf(s0[1], s1[1]));
#pragma unroll
            for (int r = 2; r < 16; r += 2) pm = fmaxf(fmaxf(pm, fmaxf(s0[r], s1[r])), fmaxf(s0[r + 1], s1[r + 1]));
            pm = fmaxf(pm, __shfl_xor(pm, 32));
            const float dl = fmaxf(__builtin_amdgcn_logf(pm), 0.f), f = __builtin_amdgcn_exp2f(-dl);
            mhat += dl; psum *= f; l_run *= f;
            nmh = -mhat;
#pragma unroll
            for (int r = 0; r < 16; ++r) { s0[r] *= f; s1[r] *= f; }
#pragma unroll
            for (int v = 0; v < 4; ++v)
#pragma unroll
                for (int r = 0; r < 16; ++r) o[v][r] *= f;
            AT_PACK(pwn);
        }
        l_run += psum;
#pragma unroll
        for (int a_ = 0; a_ < 2; ++a_)
#pragma unroll
            for (int b_ = 0; b_ < 2; ++b_) pw[a_][b_] = pwn[a_][b_];
        if (t + 2 < 64) AT_STOREK(t & 1);
        AT_STOREV((t + 1) & 1);
        __syncthreads();
    }
    AT_PV(1);
    __builtin_amdgcn_s_setprio(0);
    __syncthreads();
#undef AT_LOADK
#undef AT_LOADV
#undef AT_STOREK
#undef AT_STOREV
#undef AT_QK
#undef AT_PV
#undef AT_PACK
    const float l = l_run + __shfl_xor(l_run, 32), inv = 1.f / l;
    LAS float* ex = (LAS float*)lds;
    if (comp == 1) {
#pragma unroll
        for (int v = 0; v < 4; ++v)
#pragma unroll
            for (int r = 0; r < 16; ++r) ex[(v * 16 + r) * 256 + qs * 64 + lane] = o[v][r] * inv;
    }
    __syncthreads();
    if (comp == 0) {
        float ss = 0.f;
#pragma unroll
        for (int v = 0; v < 4; ++v)
#pragma unroll
            for (int r = 0; r < 16; ++r) { const float d = o[v][r] * inv - lam * ex[(v * 16 + r) * 256 + qs * 64 + lane]; o[v][r] = d; ss += d * d; }
        ss += __shfl_xor(ss, 32);
        const float rs = rsqrtf(ss * (1.f / 128.f) + EPS) * post_scale;
        bf16_t* op = cat + (rowb + qb * 128 + qs * 32 + r32) * D + h * 128;
        f32x4 gnv[4][4];
#pragma unroll
        for (int v = 0; v < 4; ++v)
#pragma unroll
            for (int g = 0; g < 4; ++g) gnv[v][g] = *(const GA1 f32x4*)(da_norm + v * 32 + 8 * g + 4 * hi);
#pragma unroll
        for (int v = 0; v < 4; ++v)
#pragma unroll
            for (int gp = 0; gp < 4; gp += 2) {
                const f32x4 ga = gnv[v][gp], gb = gnv[v][gp + 1];
                const unsigned ax = cvtpk(o[v][4 * gp] * rs * ga[0], o[v][4 * gp + 1] * rs * ga[1]), ay = cvtpk(o[v][4 * gp + 2] * rs * ga[2], o[v][4 * gp + 3] * rs * ga[3]);
                const unsigned bx = cvtpk(o[v][4 * gp + 4] * rs * gb[0], o[v][4 * gp + 5] * rs * gb[1]), by = cvtpk(o[v][4 * gp + 6] * rs * gb[2], o[v][4 * gp + 7] * rs * gb[3]);
                const auto r0 = __builtin_amdgcn_permlane32_swap(ax, bx, false, false), r1 = __builtin_amdgcn_permlane32_swap(ay, by, false, false);
                const u32x4 w4 = {r0[0], r1[0], r0[1], r1[1]};
                *(GA1 u32x4*)(op + v * 32 + 8 * (gp + hi)) = w4; }
    }
    __syncthreads();
}

#define GAS __attribute__((address_space(1)))
template <int DK>
__device__ __forceinline__ void walk_unit(LAS unsigned char* lds, const bf16_t* QG, const bf16_t* KG, int h, const bf16_t* Vp, const float* dec, bf16_t* Op, int opitch, int b, int dir) {
    constexpr int PQ = DK * 2 + 16, PV = 144, NCH = DK / 8, QB = 64 * PQ, VB = 64 * PV, TB = 2 * QB + VB, ST0 = 2 * TB, STB = 64 * PQ, NQ = 64 * NCH / 512, QPITCH = 4 * DK;
    static_assert(ST0 + 2 * STB <= 131072, "walk LDS");
    int tid_ = threadIdx.x; asm volatile("" : "+v"(tid_)); const int tid = tid_, lane = tid & 63, w = __builtin_amdgcn_readfirstlane(tid >> 6), r32 = lane & 31, hi = lane >> 5;
    const int i16 = lane & 15, qq = i16 >> 2, pp = i16 & 3, blk = (lane >> 4) & 1;
    u32x4 qreg[2][NQ], kreg[2][NQ], vreg[2];
    const int vrow = tid >> 3, vch = tid & 7;
#define WK_LOAD(set, n) do { const size_t t0_ = (size_t)b * SEQ + (size_t)(n) * 64; \
        _Pragma("unroll") for (int i_ = 0; i_ < NQ; ++i_) { const int id_ = tid + 512 * i_, row_ = id_ / NCH, ch_ = id_ % NCH; const size_t go_ = (t0_ + row_) * QPITCH + h * DK + ch_ * 8; \
            qreg[set][i_] = *(const GAS u32x4*)(QG + go_); kreg[set][i_] = *(const GAS u32x4*)(KG + go_); } \
        vreg[set] = *(const GAS u32x4*)(Vp + (t0_ + vrow) * PP + vch * 8); } while (0)
#define WK_STORE(set, bufi) do { LAS unsigned char* q_ = lds + (bufi) * TB; \
        _Pragma("unroll") for (int i_ = 0; i_ < NQ; ++i_) { const int id_ = tid + 512 * i_, row_ = id_ / NCH, ch_ = id_ % NCH; \
            *(LAS u32x4*)(q_ + row_ * PQ + ch_ * 16) = qreg[set][i_]; *(LAS u32x4*)(q_ + QB + row_ * PQ + ch_ * 16) = kreg[set][i_]; } \
        *(LAS u32x4*)(q_ + 2 * QB + vrow * PV + vch * 16) = vreg[set]; } while (0)
    constexpr int NB = DK / 64, NS = DK / 16;
    f32x16 sacc[NB];
#pragma unroll
    for (int j = 0; j < NB; ++j)
#pragma unroll
        for (int r = 0; r < 16; ++r) sacc[j][r] = 0.f;
    for (int e = tid; e < STB / 16; e += 512) *(LAS u32x4*)(lds + ST0 + e * 16) = (u32x4){0u, 0u, 0u, 0u};
    WK_LOAD(0, dir ? 63 : 0); WK_STORE(0, 0); WK_LOAD(0, dir ? 62 : 1); WK_LOAD(1, dir ? 61 : 2);
    const int dsd = (NB == 2 ? ((w - 4) & 3) : (((w - 4) & 3) >> 1)) * 32 + r32;
    float dl_next = *(const GAS float*)(dec + (size_t)(dir ? 63 : 0) * DK + dsd);
    __syncthreads();
    for (int i2 = 0; i2 < 64; i2 += 2)
#pragma unroll
    for (int u_ = 0; u_ < 2; ++u_) {
        const int i = i2 + u_;
        const int n = dir ? 63 - i : i;
        const float dl = dl_next;
        if (i < 63) dl_next = *(const GAS float*)(dec + (size_t)(dir ? n - 1 : n + 1) * DK + dsd);
        const size_t t0 = (size_t)b * SEQ + (size_t)n * 64;
        const LAS unsigned char* Qs = lds + u_ * TB; const LAS unsigned char* Ks = Qs + QB; const LAS unsigned char* Vs = Ks + QB;
        const LAS unsigned char* STc = lds + ST0 + u_ * STB; LAS unsigned char* STn = lds + ST0 + (u_ ^ 1) * STB;
        if (w < 4) {
            const int cb = w & 1, vb = w >> 1;
            f32x16 pt0, pt1, oacc;
#pragma unroll
            for (int r = 0; r < 16; ++r) { pt0[r] = 0.f; pt1[r] = 0.f; oacc[r] = 0.f; }
            const LAS unsigned char* vb0 = Vs + (4 * hi + qq) * PV + (vb * 32 + 16 * blk + 4 * pp) * 2;
            s16x4 vf[8];
#pragma unroll
            for (int jb = 0; jb < 2; ++jb)
#pragma unroll
                for (int s2 = 0; s2 < 2; ++s2) { const LAS unsigned char* ad = vb0 + (jb * 32 + 16 * s2) * PV; vf[(jb * 2 + s2) * 2] = vtr(ad); vf[(jb * 2 + s2) * 2 + 1] = vtr(ad + 8 * PV); }
            const LAS unsigned char* qa = Qs + (cb * 32 + r32) * PQ + hi * 16; const LAS unsigned char* ka = Ks + r32 * PQ + hi * 16; const LAS unsigned char* sa = STc + (vb * 32 + r32) * PQ + hi * 16;
            bf16x8 fq_[2], fk0[2], fk1[2], fs[2];
            fq_[0] = *(const LAS bf16x8*)qa; fk0[0] = *(const LAS bf16x8*)ka; fk1[0] = *(const LAS bf16x8*)(ka + 32 * PQ); fs[0] = *(const LAS bf16x8*)sa;
#pragma unroll
            for (int s = 0; s < NS; ++s) {
                if (s + 1 < NS) { const int o_ = (s + 1) * 32; fq_[(s + 1) & 1] = *(const LAS bf16x8*)(qa + o_); fk0[(s + 1) & 1] = *(const LAS bf16x8*)(ka + o_); fk1[(s + 1) & 1] = *(const LAS bf16x8*)(ka + 32 * PQ + o_); fs[(s + 1) & 1] = *(const LAS bf16x8*)(sa + o_); }
                __builtin_amdgcn_sched_barrier(0);
                pt0 = __builtin_amdgcn_mfma_f32_32x32x16_bf16(fk0[s & 1], fq_[s & 1], pt0, 0, 0, 0);
                pt1 = __builtin_amdgcn_mfma_f32_32x32x16_bf16(fk1[s & 1], fq_[s & 1], pt1, 0, 0, 0);
                oacc = __builtin_amdgcn_mfma_f32_32x32x16_bf16(fs[s & 1], fq_[s & 1], oacc, 0, 0, 0);
                __builtin_amdgcn_sched_barrier(0);
            }
            const int c = cb * 32 + r32;
#pragma unroll
            for (int r = 0; r < 16; ++r) { const int j0 = crow(r, hi), j1 = 32 + j0;
                const bool k0_ = dir ? (j0 >= c) : (j0 <= c), k1_ = dir ? (j1 >= c) : (j1 <= c);
                pt0[r] = k0_ ? pt0[r] : 0.f; pt1[r] = k1_ ? pt1[r] : 0.f; }
            u32x4 pw[2][2];
#pragma unroll
            for (int s2 = 0; s2 < 2; ++s2) {
                pw[0][s2] = (u32x4){cvtpk(pt0[8 * s2 + 0], pt0[8 * s2 + 1]), cvtpk(pt0[8 * s2 + 2], pt0[8 * s2 + 3]), cvtpk(pt0[8 * s2 + 4], pt0[8 * s2 + 5]), cvtpk(pt0[8 * s2 + 6], pt0[8 * s2 + 7])};
                pw[1][s2] = (u32x4){cvtpk(pt1[8 * s2 + 0], pt1[8 * s2 + 1]), cvtpk(pt1[8 * s2 + 2], pt1[8 * s2 + 3]), cvtpk(pt1[8 * s2 + 4], pt1[8 * s2 + 5]), cvtpk(pt1[8 * s2 + 6], pt1[8 * s2 + 7])};
            }
#pragma unroll
            for (int jb = 0; jb < 2; ++jb)
#pragma unroll
                for (int s2 = 0; s2 < 2; ++s2)
                    oacc = __builtin_amdgcn_mfma_f32_32x32x16_bf16(cat8(vf[(jb * 2 + s2) * 2], vf[(jb * 2 + s2) * 2 + 1]), __builtin_bit_cast(bf16x8, pw[jb][s2]), oacc, 0, 0, 0);
            bf16_t* op = Op + (t0 + c) * (size_t)opitch + vb * 32;
#pragma unroll
            for (int gp = 0; gp < 4; gp += 2) {
                const unsigned ax = cvtpk(oacc[4 * gp], oacc[4 * gp + 1]), ay = cvtpk(oacc[4 * gp + 2], oacc[4 * gp + 3]), bx = cvtpk(oacc[4 * gp + 4], oacc[4 * gp + 5]), by = cvtpk(oacc[4 * gp + 6], oacc[4 * gp + 7]);
                const auto r0 = __builtin_amdgcn_permlane32_swap(ax, bx, false, false), r1 = __builtin_amdgcn_permlane32_swap(ay, by, false, false);
                const u32x4 w4 = {r0[0], r1[0], r0[1], r1[1]};
                *(GAS u32x4*)(op + 8 * (gp + hi)) = w4; }
        } else {
            const int sdb = w - 4;
            {
                const int sd = NB == 2 ? sdb : (sdb >> 1), sv0 = NB == 2 ? 0 : (sdb & 1);
                const LAS unsigned char* kb0 = Ks + (8 * hi + qq) * PQ + (sd * 32 + 16 * blk + 4 * pp) * 2;
                s16x4 kf[8];
#pragma unroll
                for (int ks = 0; ks < 4; ++ks) { kf[2 * ks] = vtr(kb0 + 16 * ks * PQ); kf[2 * ks + 1] = vtr(kb0 + (16 * ks + 4) * PQ); }
#pragma unroll
                for (int j = 0; j < NB; ++j) {
                    const int sv = sv0 + j;
                    const LAS unsigned char* va0 = Vs + (8 * hi + qq) * PV + (sv * 32 + 16 * blk + 4 * pp) * 2;
                    s16x4 af[8];
#pragma unroll
                    for (int ks = 0; ks < 4; ++ks) { af[2 * ks] = vtr(va0 + 16 * ks * PV); af[2 * ks + 1] = vtr(va0 + (16 * ks + 4) * PV); }
#pragma unroll
                    for (int ks = 0; ks < 4; ++ks) sacc[j] = __builtin_amdgcn_mfma_f32_32x32x16_bf16(cat8(af[2 * ks], af[2 * ks + 1]), cat8(kf[2 * ks], kf[2 * ks + 1]), sacc[j], 0, 0, 0);
#pragma unroll
                    for (int r = 0; r < 16; ++r) { sacc[j][r] *= dl; *(LAS bf16_t*)(STn + (sv * 32 + crow(r, hi)) * PQ + (sd * 32 + r32) * 2) = f2bf(sacc[j][r]); }
                }
            }
        }
        if (i < 63) { WK_STORE(u_, (u_ + 1) & 1); if (i < 61) WK_LOAD(u_, dir ? n - 3 : n + 3); }
        __syncthreads();
    }
#undef WK_LOAD
#undef WK_STORE
}

template <int NPL>
__device__ __forceinline__ void post_phase(bf16_t* of, const bf16_t* ob, const bf16_t* gt, const float* gain, int gw, int NGW, int lane) {
    float gn[NPL];
#pragma unroll
    for (int i = 0; i < NPL; ++i) gn[i] = gain[(lane & 15) * NPL + i];
    constexpr int R = 4;
    for (int m0 = gw; m0 < T; m0 += R * NGW) {
        u32x4 a[R][NPL / 8], bq[R][NPL / 8], gg[R][NPL / 8];
#pragma unroll
        for (int q = 0; q < R; ++q) { const int m = (m0 + q * NGW) < T ? (m0 + q * NGW) : m0;
#pragma unroll
            for (int c = 0; c < NPL / 8; ++c) { a[q][c] = *(const GA1 u32x4*)(of + (size_t)m * D + lane * NPL + 8 * c); bq[q][c] = *(const GA1 u32x4*)(ob + (size_t)m * PP + lane * NPL + 8 * c); gg[q][c] = *(const GA1 u32x4*)(gt + (size_t)m * PP + lane * NPL + 8 * c); } }
#pragma unroll
        for (int q = 0; q < R; ++q) { const int m = m0 + q * NGW; if (m >= T) break;
            float v[NPL], g[NPL]; float ss = 0.f;
#pragma unroll
            for (int c = 0; c < NPL / 8; ++c)
#pragma unroll
                for (int e = 0; e < 4; ++e) { v[8 * c + 2 * e] = bflo(a[q][c][e]) + bflo(bq[q][c][e]); v[8 * c + 2 * e + 1] = bfhi(a[q][c][e]) + bfhi(bq[q][c][e]); g[8 * c + 2 * e] = bflo(gg[q][c][e]); g[8 * c + 2 * e + 1] = bfhi(gg[q][c][e]); }
#pragma unroll
            for (int i = 0; i < NPL; ++i) ss += v[i] * v[i];
            ss += __shfl_xor(ss, 1); ss += __shfl_xor(ss, 2); ss += __shfl_xor(ss, 4); ss += __shfl_xor(ss, 8);
            const float rs = rsqrtf(ss * (1.f / (16.f * NPL)) + EPS);
            bf16_t* pf = of + (size_t)m * D + lane * NPL;
#pragma unroll
            for (int c = 0; c < NPL / 8; ++c) { u32x4 o;
#pragma unroll
                for (int e = 0; e < 4; ++e) { const int i0 = 8 * c + 2 * e; o[e] = cvtpk(v[i0] * rs * gn[i0] * silu_f(g[i0]), v[i0 + 1] * rs * gn[i0 + 1] * silu_f(g[i0 + 1])); }
                *(GA1 u32x4*)(pf + 8 * c) = o; }
        }
    }
}

#ifdef NO_SW
#define GEMM_SW if (0)
#else
#define GEMM_SW
#endif
#ifdef NO_RES
#define GEMM_RES if (0)
#else
#define GEMM_RES
#endif
#ifdef NO_PROJ
#define GEMM_PROJ if (0)
#else
#define GEMM_PROJ
#endif
constexpr int LDS_BYTES = 147456;
struct Args { const void* in[30]; float* out; unsigned char* ws; };
#define INF(i) ((const float*)args.in[i])

constexpr int NPHASE = 20;
#ifndef DBG_STOP
#define DBG_STOP NPHASE
#endif
__global__ void __launch_bounds__(512, 2) mega_fwd(Args args) {
    extern __shared__ __attribute__((aligned(16))) unsigned char lds_raw[];
    LAS unsigned char* lds = (LAS unsigned char*)lds_raw;
    cg::grid_group grid = cg::this_grid();
    volatile LAS unsigned* MISC = (volatile LAS unsigned*)(lds + 131072 + 320);
    if (threadIdx.x < 64) MISC[threadIdx.x] = 0u;
    __syncthreads();
    grid.sync();
    XcdBarrier bar = xcd_barrier_post((unsigned*)args.ws + 4096, MISC + 8);
    if (threadIdx.x == 0) { const unsigned x_ = xb_xcc_id(); const unsigned r_ = __hip_atomic_fetch_add((unsigned*)args.ws + 64 + x_, 1u, __ATOMIC_RELAXED, __HIP_MEMORY_SCOPE_AGENT); MISC[20] = r_; MISC[21] = x_; MISC[22] = blockIdx.x; }
    __syncthreads();
#pragma unroll 1
    for (int ph = 0; ph < NPHASE; ++ph) {
        if (ph == 1) {
            if (threadIdx.x == 0) { bool ok_ = gridDim.x == 256;
                for (int j = 0; j < 8; ++j) ok_ = ok_ && (__hip_atomic_load((unsigned*)args.ws + 64 + j, __ATOMIC_RELAXED, __HIP_MEMORY_SCOPE_AGENT) == 32u);
                if (ok_) MISC[22] = MISC[20] * 8u + MISC[21]; }
            __syncthreads();
        }
        int tid_ = threadIdx.x; asm volatile("" : "+v"(tid_)); int bid_ = (int)__builtin_amdgcn_readfirstlane((int)MISC[22]); asm volatile("" : "+s"(bid_));
        const int tid = tid_, lane = tid & 63, wave = __builtin_amdgcn_readfirstlane(tid >> 6);
        const int G = gridDim.x, gw = bid_ * 8 + wave, NGW = G * 8;
        unsigned char* ws = args.ws; asm volatile("" : "+s"(ws));
        float* xfin = (float*)(ws + WS_C);
        bf16_t* A = (bf16_t*)(ws + WS_A); bf16_t* B = (bf16_t*)(ws + WS_B);
        bf16_t* XB = (bf16_t*)args.out;
        bf16_t* QGf = (bf16_t*)(ws + WS_C); bf16_t* KGf = (bf16_t*)(ws + WS_C + 32 * MiB); bf16_t* QGb = (bf16_t*)(ws + WS_C + 64 * MiB); bf16_t* KGb = (bf16_t*)(ws + WS_C + 96 * MiB);
        float* LR = (float*)(ws + WS_LR); float* DECf = (float*)(ws + WS_DEC); float* DECb = (float*)(ws + WS_DEC + 1 * MiB);
        float* SSB = (float*)(ws + WS_SS);
        const int layer = ph > 9 ? 1 : 0, step = (ph == 0 || ph == NPHASE - 1) ? -1 : (ph - 1) - 9 * layer;
        if (ph >= DBG_STOP && ph != NPHASE - 1) {
        } else if (ph == 0) {
            {
            LAS float* scr = (LAS float*)(lds + wave * 16384);
            int it = gw;
#pragma unroll 1
            for (int f = 0; f < 4; ++f) {
                const int ly = f >> 1, which = f & 1;
                const float* wg = INF(which ? 7 : 3) + (size_t)ly * D * FF; const float* wu = INF(which ? 8 : 4) + (size_t)ly * D * FF; const float* wd = INF(which ? 9 : 5) + (size_t)ly * FF * D;
                const float* gn = INF(which ? 6 : 2) + ly * D;
                bf16_t* gu = (bf16_t*)(ws + WS_WGU) + (size_t)f * 5632 * 1024; bf16_t* dn = (bf16_t*)(ws + WS_WD) + (size_t)f * 1024 * 2816;
                constexpr int IG = 16 * 88, ID = 44 * 32;
                for (; it < IG; it += NGW) tr_item(wg, D, FF, gu, 1, 1.f, 0, 0, gn, scr, it, lane);
                it -= IG;
                for (; it < IG; it += NGW) tr_item(wu, D, FF, gu, 2, 1.f, 0, 0, gn, scr, it, lane);
                it -= IG;
                for (; it < ID; it += NGW) tr_item(wd, FF, D, dn, 0, 1.f, 0, 0, nullptr, scr, it, lane);
                it -= ID;
            }
            {
                constexpr int I0 = 16 * 96, I1 = 16 * 32, I2 = 16 * 97;
                for (; it < I0; it += NGW) tr_item(INF(11), D, 3072, (bf16_t*)(ws + WS_WIN0), 0, 0.125f * 1.4426950408889634f, 0, 512, INF(10), scr, it, lane);
                it -= I0;
                for (; it < I1; it += NGW) tr_item(INF(20), D, D, (bf16_t*)(ws + WS_WOUT0), 0, 1.f, 0, 0, nullptr, scr, it, lane);
                it -= I1;
                for (; it < I2; it += NGW) tr_item(INF(22), D, 3104, (bf16_t*)(ws + WS_WIN1), 0, 0.08838834764831845f, 0, 512, INF(21), scr, it, lane);
                it -= I2;
                for (; it < I1; it += NGW) tr_item(INF(28), D, D, (bf16_t*)(ws + WS_WOUT1), 0, 1.f, 0, 0, nullptr, scr, it, lane);
            }
            { GA1 u32x4* z = (GA1 u32x4*)((bf16_t*)(ws + WS_WIN1) + (size_t)3104 * 1024); for (int e = bid_ * 512 + tid; e < 224 * 1024 / 8; e += G * 512) z[e] = (u32x4){0u, 0u, 0u, 0u}; }
            }
#ifdef DBL_PRO2
            {
            LAS float* scr = (LAS float*)(lds + wave * 16384);
            int it = gw;
#pragma unroll 1
            for (int f = 0; f < 4; ++f) {
                const int ly = f >> 1, which = f & 1;
                const float* wg = INF(which ? 7 : 3) + (size_t)ly * D * FF; const float* wu = INF(which ? 8 : 4) + (size_t)ly * D * FF; const float* wd = INF(which ? 9 : 5) + (size_t)ly * FF * D;
                const float* gn = INF(which ? 6 : 2) + ly * D;
                bf16_t* gu = (bf16_t*)(ws + WS_WGU) + (size_t)f * 5632 * 1024; bf16_t* dn = (bf16_t*)(ws + WS_WD) + (size_t)f * 1024 * 2816;
                constexpr int IG = 16 * 88, ID = 44 * 32;
                for (; it < IG; it += NGW) tr_item(wg, D, FF, gu, 1, 1.f, 0, 0, gn, scr, it, lane);
                it -= IG;
                for (; it < IG; it += NGW) tr_item(wu, D, FF, gu, 2, 1.f, 0, 0, gn, scr, it, lane);
                it -= IG;
                for (; it < ID; it += NGW) tr_item(wd, FF, D, dn, 0, 1.f, 0, 0, nullptr, scr, it, lane);
                it -= ID;
            }
            {
                constexpr int I0 = 16 * 96, I1 = 16 * 32, I2 = 16 * 97;
                for (; it < I0; it += NGW) tr_item(INF(11), D, 3072, (bf16_t*)(ws + WS_WIN0), 0, 0.125f * 1.4426950408889634f, 0, 512, INF(10), scr, it, lane);
                it -= I0;
                for (; it < I1; it += NGW) tr_item(INF(20), D, D, (bf16_t*)(ws + WS_WOUT0), 0, 1.f, 0, 0, nullptr, scr, it, lane);
                it -= I1;
                for (; it < I2; it += NGW) tr_item(INF(22), D, 3104, (bf16_t*)(ws + WS_WIN1), 0, 0.08838834764831845f, 0, 512, INF(21), scr, it, lane);
                it -= I2;
                for (; it < I1; it += NGW) tr_item(INF(28), D, D, (bf16_t*)(ws + WS_WOUT1), 0, 1.f, 0, 0, nullptr, scr, it, lane);
            }
            { GA1 u32x4* z = (GA1 u32x4*)((bf16_t*)(ws + WS_WIN1) + (size_t)3104 * 1024); for (int e = bid_ * 512 + tid; e < 224 * 1024 / 8; e += G * 512) z[e] = (u32x4){0u, 0u, 0u, 0u}; }
            }
#endif
            cast_phase(INF(0), XB, SSB, gw, NGW, lane);
        } else if (ph == NPHASE - 1) {
            final_phase(A, SSB + (size_t)6 * T * 16, INF(29), args.out, gw, NGW, lane);
        } else if (step == 0 || step == 7) {
            const int f = layer * 2 + (step == 7 ? 1 : 0);
            pg8::Gemm g{XB, (const bf16_t*)(ws + WS_WGU) + (size_t)f * 5632 * 1024, T, 5632, D}; pg8::StaticOrder S; S.init(T, 5632, G, bid_);
            EpiSwiglu E{B, SSB + (size_t)(3 * layer + (step == 7 ? 2 : 0)) * T * 16};
            GEMM_SW pg8::gemm_phase<EpiSwiglu, pg8::StaticOrder, true, true>(lds, g, S, E);
#ifdef DBL_GU
            GEMM_SW pg8::gemm_phase<EpiSwiglu, pg8::StaticOrder, true, true>(lds, g, S, E);
#endif
        } else if (step == 1 || step == 8 || step == 6) {
            const int f = layer * 2 + (step == 8 ? 1 : 0);
            const bf16_t* Am = step == 6 ? A : B;
            const bf16_t* Wm = step == 6 ? (const bf16_t*)(ws + (layer == 0 ? WS_WOUT0 : WS_WOUT1)) : (const bf16_t*)(ws + WS_WD) + (size_t)f * 1024 * 2816;
            pg8::Gemm g{Am, Wm, T, D, step == 6 ? D : FF}; pg8::StaticOrder S; S.init(T, D, G, bid_);
            const bool last = (layer == 1 && step == 8);
            const bf16_t* e_xb = XB; bf16_t* e_out = last ? A : XB; float e_alpha = step == 6 ? 1.0f : 0.5f; float* e_ss = SSB + (size_t)(3 * layer + (step == 1 ? 1 : step == 6 ? 2 : 3)) * T * 16;
            asm volatile("" : "+s"(e_xb), "+s"(e_out), "+s"(e_alpha), "+s"(e_ss));
            EpiRes E{e_xb, e_out, e_alpha, e_ss};
            GEMM_RES pg8::gemm_phase<EpiRes, pg8::StaticOrder, true, true>(lds, g, S, E);
        } else if (step == 2) {
            const int N = layer == 0 ? 3072 : 3328;
            pg8::Gemm g{XB, (const bf16_t*)(ws + (layer == 0 ? WS_WIN0 : WS_WIN1)), T, N, D}; pg8::StaticOrder S; S.init(T, N, G, bid_);
            EpiProj E{B, LR, SSB + (size_t)(3 * layer + 1) * T * 16};
            GEMM_PROJ pg8::gemm_phase<EpiProj, pg8::StaticOrder, true, true>(lds, g, S, E);
#ifdef DBL_PROJ
            GEMM_PROJ pg8::gemm_phase<EpiProj, pg8::StaticOrder, true, true>(lds, g, S, E);
#endif
        } else if (step == 3) {
            if (layer == 0) prep0_phase(B, (const int*)args.in[1], INF(17), INF(18), QGf, KGf, QGb, KGb, DECf, DECb, gw, NGW, lane);
            else { prep1_phase(B, LR, INF(23), INF(24), INF(25), INF(26), QGf, KGf, QGb, KGb, DECf, DECb, tid, lds, bid_, G);
#ifdef DBL_PREP1
                prep1_phase(B, LR, INF(23), INF(24), INF(25), INF(26), QGf, KGf, QGb, KGb, DECf, DECb, tid, lds, bid_, G);
#endif
 }
        } else if (step == 4) {
            if (layer == 0) {
                float s1 = 0.f, s2 = 0.f;
                for (int i = 0; i < 64; ++i) { s1 += INF(12)[i] * INF(13)[i]; s2 += INF(14)[i] * INF(15)[i]; }
                const float lam_init = 0.2f, lam = expf(s1) - expf(s2) + lam_init;
#ifndef SKIP_ATTN
#pragma unroll 1
                for (int u = bid_; u < 1024; u += G) { const int i = u >> 8, bx = u & 255, bh = (bx & 7) * 4 + i, qb = bx >> 3;
                    attn_unit(lds, B, A, bh >> 2, bh & 3, qb, lam, INF(16), 1.f - lam_init);
#ifdef DBL_ATTN
                    attn_unit(lds, B, A, bh >> 2, bh & 3, qb, lam, INF(16), 1.f - lam_init);
#endif
 }
#endif
#ifndef SKIP_WALK
#pragma unroll 1
                for (int u = bid_; u < 128; u += G) { const int x = u & 7, y = u >> 3, vs = y & 1, dir = (y >> 1) & 1, bh = x * 4 + (y >> 2), b = bh >> 2, h = bh & 3;
#define WALK0_CALL                     walk_unit<64>(lds, dir ? QGb : QGf, dir ? KGb : KGf, h, B + 2048 + h * 128 + vs * 64, (dir ? DECb : DECf) + (size_t)bh * 64 * 64, \
                                  dir ? (B + 1536 + h * 128 + vs * 64) : (A + 512 + h * 128 + vs * 64), dir ? PP : D, b, dir);
                    WALK0_CALL
#ifdef DBL_WALK
                    WALK0_CALL
#endif
 }
#endif
            } else {
#ifndef SKIP_WALK
#pragma unroll 1
                for (int u = bid_; u < 256; u += G) { const int x = u & 7, y = u >> 3, vs = y & 3, dir = (y >> 2) & 1, bh = x * 4 + (y >> 3), b = bh >> 2, h = bh & 3;
#define WALK1_CALL                     walk_unit<128>(lds, dir ? QGb : QGf, dir ? KGb : KGf, h, B + 1024 + h * 256 + vs * 64, (dir ? DECb : DECf) + (size_t)bh * 64 * 128, \
                                   dir ? (B + h * 256 + vs * 64) : (A + h * 256 + vs * 64), dir ? PP : D, b, dir);
                    WALK1_CALL
#ifdef DBL_WALK
                    WALK1_CALL
#endif
 }
#endif
            }
        } else if (step == 5) {
            if (layer == 0) post_phase<8>(A + 512, B + 1536, B + 2560, INF(19), gw, NGW, lane);
            else post_phase<16>(A, B, B + 2048, INF(27), gw, NGW, lane);
        }
        if (ph + 1 < NPHASE) xcd_barrier(bar);
#ifdef DBL_BAR
        if (ph + 1 < NPHASE) xcd_barrier(bar);
#endif
    }
}

extern "C" void kernel_launch(void* const* d_in, const int* in_sizes, int n_in, void* d_out, int out_size, void* d_ws, size_t ws_size, hipStream_t stream) {
    static int grid = 0;
    if (grid == 0) {
        if (n_in != 30 || out_size != T * D || ws_size < WS_END) { fprintf(stderr, "kernel_launch: unexpected shapes (n_in %d out %d ws %zu)\n", n_in, out_size, ws_size); grid = -1; return; }
        int dev = 0, cus = 0, per_cu = 0;
        (void)hipGetDevice(&dev); (void)hipDeviceGetAttribute(&cus, hipDeviceAttributeMultiprocessorCount, dev);
        if (hipFuncSetAttribute((const void*)mega_fwd, hipFuncAttributeMaxDynamicSharedMemorySize, LDS_BYTES) != hipSuccess) { fprintf(stderr, "kernel_launch: hipFuncSetAttribute failed\n"); }
        if (hipOccupancyMaxActiveBlocksPerMultiprocessor(&per_cu, (const void*)mega_fwd, 512, LDS_BYTES) != hipSuccess || per_cu < 1) per_cu = 1;
        (void)hipGetLastError();
        grid = cus * per_cu;
        if (grid <= 0) grid = 256;
    }
    if (grid < 0) return;
    Args a{};
    for (int i = 0; i < 30; ++i) a.in[i] = d_in[i];
    a.out = (float*)d_out; a.ws = (unsigned char*)d_ws;
    (void)hipMemsetAsync(d_ws, 0, 65536, stream);
    void* kargs[] = {&a};
    hipError_t e = hipLaunchCooperativeKernel((const void*)mega_fwd, dim3(grid), dim3(512), kargs, LDS_BYTES, stream);
    if (e != hipSuccess) fprintf(stderr, "cooperative launch failed: %s (grid %d)\n", hipGetErrorString(e), grid);
}
```
